# Optimizing an MI355X kernel written in HIP

```python
import math
import jax, jax.numpy as jnp
from jax import lax
import numpy as np

D_MODEL = 2048
BATCH = 4
SEQ = 2048
DEPTH = 4

N_META = 16
D_MIX = D_MODEL
DA_HEADS = 8
DA_HEAD_DIM = 64
DA_WIDTH = DA_HEADS * 2 * DA_HEAD_DIM
GLA_HEADS = 4
GLA_WIDTH = D_MIX - DA_WIDTH
GLA_HEAD_V = GLA_WIDTH // GLA_HEADS
GLA_KEY_WIDTH = GLA_WIDTH // 2
GLA_HEAD_K = GLA_KEY_WIDTH // GLA_HEADS
GLA_GATE_RANK = 16
GLA_GATE_NORM = 16.0
GLA_CHUNK = 64
Q_BLOCK = 128
D_FF = 5632
CONV_W = 3
EPS = 1e-6
IN_SPLITS = (DA_WIDTH, DA_WIDTH, DA_WIDTH, GLA_KEY_WIDTH, GLA_KEY_WIDTH, GLA_WIDTH, GLA_WIDTH, GLA_GATE_RANK)
IN_COLS = sum(IN_SPLITS)

kernel_name = "hymba_diffattn_gla_convffn_trunk"


def rmsnorm(x, g):
    xf = x.astype(jnp.float32)
    y = xf * lax.rsqrt(jnp.mean(xf * xf, axis=-1, keepdims=True) + EPS) * g.astype(jnp.float32)
    return y.astype(x.dtype)


def split_cols(p):
    idx = np.cumsum(IN_SPLITS)[:-1].tolist()
    return jnp.split(p, idx, axis=-1)


def diff_attention(q, k, v, lam, subln_g, lam_init):
    dtype = q.dtype
    B, L, _ = q.shape
    Lp = -(-L // Q_BLOCK) * Q_BLOCK
    nb = Lp // Q_BLOCK
    pad = ((0, 0), (0, Lp - L), (0, 0))
    q = jnp.pad(q.astype(jnp.float32), pad).reshape(B, Lp, DA_HEADS, 2, DA_HEAD_DIM).transpose(0, 2, 3, 1, 4)
    k = jnp.pad(k.astype(jnp.float32), pad).reshape(B, Lp, DA_HEADS, 2, DA_HEAD_DIM).transpose(0, 2, 3, 1, 4)
    v = jnp.pad(v.astype(jnp.float32), pad).reshape(B, Lp, DA_HEADS, 2 * DA_HEAD_DIM).transpose(0, 2, 1, 3)
    q_blocks = q.reshape(B, DA_HEADS, 2, nb, Q_BLOCK, DA_HEAD_DIM).transpose(3, 0, 1, 2, 4, 5)
    kpos = jnp.arange(Lp)
    scale = DA_HEAD_DIM ** -0.5

    def block(args):
        qb, blk = args
        s = jnp.einsum('bhcqd,bhckd->bhcqk', qb, k) * scale
        qpos = blk * Q_BLOCK + jnp.arange(Q_BLOCK)
        mask = kpos[None, :] <= qpos[:, None]
        s = jnp.where(mask, s, -jnp.inf)
        p = jax.nn.softmax(s, axis=-1)
        p_diff = p[:, :, 0] - lam * p[:, :, 1]
        return jnp.einsum('bhqk,bhke->bhqe', p_diff, v)

    o = lax.map(block, (q_blocks, jnp.arange(nb)))
    o = o.transpose(1, 0, 3, 2, 4).reshape(B, Lp, DA_HEADS, 2 * DA_HEAD_DIM)[:, :L]
    o = rmsnorm(o, subln_g) * (1.0 - lam_init)
    return o.reshape(B, L, DA_WIDTH).astype(dtype)


def gla(q, k, v, g_out, gate_lr, w2, b2, norm_g):
    dtype = v.dtype
    B, L, _ = v.shape
    f32 = jnp.float32
    gk = jax.nn.log_sigmoid(gate_lr.astype(f32) @ w2.astype(f32) + b2.astype(f32)) / GLA_GATE_NORM
    P = GLA_CHUNK - N_META
    T = P + L
    N = T // GLA_CHUNK
    pad = ((0, 0), (P, 0), (0, 0))

    def chunks(t, hd):
        t = jnp.pad(t.astype(f32), pad).reshape(B, N, GLA_CHUNK, GLA_HEADS, hd)
        return t.transpose(0, 3, 1, 2, 4)

    qc = chunks(q, GLA_HEAD_K) * (GLA_HEAD_K ** -0.5)
    kc = chunks(k, GLA_HEAD_K)
    vc = chunks(v, GLA_HEAD_V)
    gc = chunks(gk, GLA_HEAD_K)
    b = jnp.cumsum(gc, axis=3)
    q_in = qc * jnp.exp(b)
    k_in = kc * jnp.exp(-b)
    A = jnp.einsum('bhnid,bhnjd->bhnij', q_in, k_in)
    tril = jnp.tril(jnp.ones((GLA_CHUNK, GLA_CHUNK), dtype=bool))
    A = jnp.where(tril, A, 0.0)
    o_intra = jnp.einsum('bhnij,bhnjv->bhniv', A, vc)
    b_last = b[:, :, :, -1:, :]
    chunk_kv = jnp.einsum('bhncd,bhncv->bhndv', kc * jnp.exp(b_last - b), vc)
    decay = jnp.exp(b_last[:, :, :, 0, :])

    def step(S, inp):
        dec, kv = inp
        return dec[..., None] * S + kv, S

    S0 = jnp.zeros((B, GLA_HEADS, GLA_HEAD_K, GLA_HEAD_V), f32)
    _, S_prev = lax.scan(step, S0, (jnp.moveaxis(decay, 2, 0), jnp.moveaxis(chunk_kv, 2, 0)))
    S_prev = jnp.moveaxis(S_prev, 0, 2)
    o_inter = jnp.einsum('bhncd,bhndv->bhncv', q_in, S_prev)
    o = (o_intra + o_inter).transpose(0, 2, 3, 1, 4).reshape(B, T, GLA_HEADS, GLA_HEAD_V)[:, P:]
    o = rmsnorm(o, norm_g).reshape(B, L, GLA_WIDTH)
    return (o * jax.nn.silu(g_out.astype(f32))).astype(dtype)


def conv_ffn(h, w_up, conv_w, conv_b, w_down):
    L = h.shape[1]
    u = h @ w_up
    up = jnp.pad(u, ((0, 0), (CONV_W - 1, 0), (0, 0)))
    uc = conv_b + sum(conv_w[i] * up[:, i:i + L] for i in range(CONV_W))
    a, val = jnp.split(uc, 2, axis=-1)
    return (jax.nn.silu(a) * val) @ w_down


def setup_inputs(seed: int = 0) -> dict:
    key = jax.random.key(seed)
    ks = jax.random.split(key, 20)
    f32 = jnp.float32

    def nrm(k, shape, scale):
        return jax.random.normal(k, shape, f32) * scale

    def gain(k, shape):
        return 1.0 + 0.05 * jax.random.normal(k, shape, f32)

    return {
        "x": nrm(ks[0], (BATCH, SEQ, D_MODEL), 1.0),
        "meta_tokens": nrm(ks[1], (N_META, D_MODEL), 1.0),
        "pre_mix_g": gain(ks[2], (DEPTH, D_MODEL)),
        "w_in": nrm(ks[3], (DEPTH, D_MODEL, IN_COLS), D_MODEL ** -0.5),
        "da_lambda": nrm(ks[4], (DEPTH, 4, DA_HEAD_DIM), 0.1),
        "da_subln_g": gain(ks[5], (DEPTH, 2 * DA_HEAD_DIM)),
        "gla_gate_w2": nrm(ks[6], (DEPTH, GLA_GATE_RANK, GLA_KEY_WIDTH), GLA_GATE_RANK ** -0.5),
        "gla_gate_b": nrm(ks[7], (DEPTH, GLA_KEY_WIDTH), 0.01),
        "gla_norm_g": gain(ks[8], (DEPTH, GLA_HEAD_V)),
        "w_out": nrm(ks[9], (DEPTH, D_MIX, D_MODEL), D_MIX ** -0.5),
        "post_mix_g": gain(ks[10], (DEPTH, D_MODEL)),
        "pre_ffn_g": gain(ks[11], (DEPTH, D_MODEL)),
        "w_up": nrm(ks[12], (DEPTH, D_MODEL, 2 * D_FF), D_MODEL ** -0.5),
        "conv_w": nrm(ks[13], (DEPTH, CONV_W, 2 * D_FF), CONV_W ** -0.5),
        "conv_b": nrm(ks[14], (DEPTH, 2 * D_FF), 0.01),
        "w_down": nrm(ks[15], (DEPTH, D_FF, D_MODEL), D_FF ** -0.5),
        "post_ffn_g": gain(ks[16], (DEPTH, D_MODEL)),
    }


def reference(x, meta_tokens, pre_mix_g, w_in, da_lambda, da_subln_g, gla_gate_w2, gla_gate_b,
              gla_norm_g, w_out, post_mix_g, pre_ffn_g, w_up, conv_w, conv_b, w_down, post_ffn_g):
    B = x.shape[0]
    meta = jnp.broadcast_to(meta_tokens.astype(x.dtype)[None], (B, N_META, D_MODEL))
    h_res = jnp.concatenate([meta, x], axis=1)
    for l in range(DEPTH):
        lam_init = 0.8 - 0.6 * math.exp(-0.3 * l)
        h = rmsnorm(h_res, pre_mix_g[l])
        q_da, k_da, v_da, q_g, k_g, v_g, g_g, lr_g = split_cols(h @ w_in[l])
        lamv = da_lambda[l].astype(jnp.float32)
        lam = jnp.exp(jnp.sum(lamv[0] * lamv[1])) - jnp.exp(jnp.sum(lamv[2] * lamv[3])) + lam_init
        o_da = diff_attention(q_da, k_da, v_da, lam, da_subln_g[l], lam_init)
        o_gla = gla(q_g, k_g, v_g, g_g, lr_g, gla_gate_w2[l], gla_gate_b[l], gla_norm_g[l])
        y = jnp.concatenate([o_da, o_gla], axis=-1) @ w_out[l]
        h_res = h_res + rmsnorm(y, post_mix_g[l])
        h = rmsnorm(h_res, pre_ffn_g[l])
        y = conv_ffn(h, w_up[l], conv_w[l], conv_b[l], w_down[l])
        h_res = h_res + rmsnorm(y, post_ffn_g[l])
    return h_res[:, N_META:]
```

```cpp
#include <hip/hip_runtime.h>
#include <hip/hip_cooperative_groups.h>
#include <cstdio>
#include <cstdint>
namespace cg = cooperative_groups;
#define MULTI_LAUNCH 0

namespace pg8 {
#define PG8_LAS __attribute__((address_space(3)))
typedef unsigned short bf16_t;
typedef short bf16x8 __attribute__((ext_vector_type(8)));
typedef float f32x4 __attribute__((ext_vector_type(4)));
typedef unsigned u32x4 __attribute__((ext_vector_type(4)));
constexpr int BM = 256, BK = 64, HALF = 128, HTB = HALF * BK * 2  , STAGE_BYTES = 8 * HTB, NXCD = 8, WGM = 8;

__host__ __device__ __forceinline__ int lds_byte(int r, int c) { const int st = (r >> 4) * 2 + (c >> 5), rr = r & 15, cc = c & 31, ob = rr * 64 + cc * 2; return st * 1024 + (ob ^ (((ob >> 9) & 1) << 5)); }
__host__ __device__ __forceinline__ void stage_rc(int b, int& R, int& C) { const int st = b / 1024, sb = b % 1024, swz = sb ^ (((sb >> 9) & 1) << 5); R = (st >> 1) * 16 + swz / 64; C = (st & 1) * 32 + (swz % 64) / 2; }
__host__ __device__ __forceinline__ int perm32(int rho) { const int n = rho >> 4, i = rho & 15; return 8 * (i >> 2) + 4 * n + (i & 3); }

struct Unit { int pm, pn; };
struct Gemm { const bf16_t* A; const bf16_t* Bt; int M, N, K; };

struct StaticOrder {
    int nM, nN, nwg, G, c;
    __host__ __device__ void init(int M, int N, int G_, int c_) { nM = M / BM; nN = N / BM; nwg = nM * nN; G = G_; c = c_; }
    __host__ __device__ bool next(int i, Unit& u) const {
        const long L = (long)i * G + c; if (L >= nwg) return false;
        int wgid = (int)L; { const int q = nwg / NXCD, r = nwg % NXCD, xcd = wgid % NXCD, off = wgid / NXCD; wgid = (xcd < r ? xcd * (q + 1) : r * (q + 1) + (xcd - r) * q) + off; }
        const int nig = WGM * nN, gid = wgid / nig, fm = gid * WGM, gsz = (nM - fm) < WGM ? (nM - fm) : WGM;
        u.pm = fm + ((wgid % nig) % gsz); u.pn = (wgid % nig) / gsz; return true;
    }
    __device__ __forceinline__ void a_ready(const Unit&) const {}
    __device__ __forceinline__ void done(const Unit&) const {}
};
__device__ __forceinline__ unsigned cvt_pk_bf16(float lo, float hi) { unsigned r; asm volatile("v_cvt_pk_bf16_f32 %0, %1, %2" : "=v"(r) : "v"(lo), "v"(hi)); return r; }

struct EpiF32 {
    static constexpr bool PERM = false, AFTER_DRAIN = false;
    float* O; int ldc;
    __device__ __forceinline__ void operator()(const f32x4 (&acc)[2][2][4][2], const Unit& u, int wr, int wc, int fr, int fq) const {
        const int row0 = u.pm * BM + wr * 64 + fr, col0 = u.pn * BM + wc * 32 + 4 * fq;
#pragma unroll
        for (int ai = 0; ai < 2; ++ai)
#pragma unroll
            for (int m = 0; m < 4; ++m) { float* rowp = O + (size_t)(row0 + ai * HALF + m * 16) * ldc + col0;
#pragma unroll
                for (int bj = 0; bj < 2; ++bj)
#pragma unroll
                    for (int n = 0; n < 2; ++n) *(f32x4*)(rowp + bj * HALF + n * 16) = acc[ai][bj][m][n]; }
    }
};
struct EpiB16 {
    static constexpr bool PERM = true, AFTER_DRAIN = false;
    bf16_t* O; int ldc;
    __device__ __forceinline__ void operator()(const f32x4 (&acc)[2][2][4][2], const Unit& u, int wr, int wc, int fr, int fq) const {
        const int row0 = u.pm * BM + wr * 64 + fr, col0 = u.pn * BM + wc * 32 + 8 * fq;
#pragma unroll
        for (int ai = 0; ai < 2; ++ai)
#pragma unroll
            for (int m = 0; m < 4; ++m) { bf16_t* rowp = O + (size_t)(row0 + ai * HALF + m * 16) * ldc + col0;
#pragma unroll
                for (int bj = 0; bj < 2; ++bj) { const f32x4 v0 = acc[ai][bj][m][0], v1 = acc[ai][bj][m][1];
                    u32x4 w; w.x = cvt_pk_bf16(v0[0], v0[1]); w.y = cvt_pk_bf16(v0[2], v0[3]); w.z = cvt_pk_bf16(v1[0], v1[1]); w.w = cvt_pk_bf16(v1[2], v1[3]);
                    *(u32x4*)(rowp + bj * HALF) = w; } }
    }
};
struct EpiIn {
    static constexpr bool PERM = true, AFTER_DRAIN = false;
    bf16_t* P; int ldc; bf16_t* VtA; bf16_t* VtB; int LPtok; float qscale;
    __device__ __forceinline__ void operator()(const f32x4 (&acc)[2][2][4][2], const Unit& u, int wr, int wc, int fr, int fq) const {
        const int row0 = u.pm * BM + wr * 64 + fr, col0 = u.pn * BM + wc * 32 + 8 * fq;
        const bool isva = (u.pn >= 8 && u.pn < 12), isvb = (u.pn >= 16 && u.pn < 20);
        if (isva || isvb) {
            bf16_t* Vt = isva ? VtA : VtB; const int cbase = col0 - (isva ? 2048 : 4096);
#pragma unroll
            for (int ai = 0; ai < 2; ++ai)
#pragma unroll
                for (int m = 0; m < 4; ++m) { const int row = row0 + ai * HALF + m * 16; const int b = row / LPtok, t = row - b * LPtok;
#pragma unroll
                    for (int bj = 0; bj < 2; ++bj) { const f32x4 v0 = acc[ai][bj][m][0], v1 = acc[ai][bj][m][1];
                        const unsigned w0 = cvt_pk_bf16(v0[0], v0[1]), w1 = cvt_pk_bf16(v0[2], v0[3]), w2 = cvt_pk_bf16(v1[0], v1[1]), w3 = cvt_pk_bf16(v1[2], v1[3]);
                        bf16_t* dst = Vt + ((size_t)b * 1024 + cbase + bj * HALF) * LPtok + t;
                        dst[0] = (bf16_t)(w0 & 0xffffu); dst[(size_t)LPtok] = (bf16_t)(w0 >> 16); dst[(size_t)2 * LPtok] = (bf16_t)(w1 & 0xffffu); dst[(size_t)3 * LPtok] = (bf16_t)(w1 >> 16);
                        dst[(size_t)4 * LPtok] = (bf16_t)(w2 & 0xffffu); dst[(size_t)5 * LPtok] = (bf16_t)(w2 >> 16); dst[(size_t)6 * LPtok] = (bf16_t)(w3 & 0xffffu); dst[(size_t)7 * LPtok] = (bf16_t)(w3 >> 16); } }
        } else {
            const float sc = (u.pn < 4) ? qscale : 1.f;
#pragma unroll
            for (int ai = 0; ai < 2; ++ai)
#pragma unroll
                for (int m = 0; m < 4; ++m) { bf16_t* rowp = P + (size_t)(row0 + ai * HALF + m * 16) * ldc + col0;
#pragma unroll
                    for (int bj = 0; bj < 2; ++bj) { const f32x4 v0 = acc[ai][bj][m][0] * sc, v1 = acc[ai][bj][m][1] * sc;
                        u32x4 w; w.x = cvt_pk_bf16(v0[0], v0[1]); w.y = cvt_pk_bf16(v0[2], v0[3]); w.z = cvt_pk_bf16(v1[0], v1[1]); w.w = cvt_pk_bf16(v1[2], v1[3]);
                        *(u32x4*)(rowp + bj * HALF) = w; } }
        }
    }
};

template <class Epi, class Sched, bool ALIGN_EPI = false, bool SP2 = false>
__device__ __forceinline__ void gemm_phase(PG8_LAS unsigned char* lds, const Gemm g, const Sched& S, const Epi& E) {
    int tid_ = threadIdx.x; asm volatile("" : "+v"(tid_));
    const int tid = tid_, wid = __builtin_amdgcn_readfirstlane(tid >> 6), lane = tid & 63, wr = wid >> 2, wc = wid & 3, fr = lane & 15, fq = lane >> 4;
    const int K = g.K, nt = K / BK;
    unsigned voffA[2], voffB[2];
#pragma unroll
    for (int i = 0; i < 2; ++i) { int R, C; stage_rc(tid * 16 + i * 8192, R, C); const int Rb = Epi::PERM ? ((R & ~31) + perm32(R & 31)) : R;
        voffA[i] = (unsigned)(R * K + C) * 2u; voffB[i] = (unsigned)(Rb * K + C) * 2u; }
    const size_t kstep = (size_t)(BK * 2);
    const size_t hstep = (size_t)HALF * K * 2;
    const size_t tstep = 2 * hstep;
    const unsigned ldsw = (unsigned)wid * 1024u;
    const int aoff = lds_byte(wr * 64 + fr, fq * 8), boff = lds_byte(wc * 32 + fr, fq * 8);
#define PG8_SA(b, h) (((b) * 2 + (h)) * HTB)
#define PG8_SB(b, h) ((4 + (b) * 2 + (h)) * HTB)
#define PG8_STAGE(bufoff, gbase, voff) do { _Pragma("unroll") for (int _i = 0; _i < 2; ++_i) \
        __builtin_amdgcn_global_load_lds((const unsigned*)((const char*)(gbase) + (voff)[_i]), (PG8_LAS unsigned*)(lds + (bufoff) + ldsw + _i * 8192), 16, 0, 0); } while (0)
#define PG8_LDA(dst, b, h) do { _Pragma("unroll") for (int m = 0; m < 4; ++m) _Pragma("unroll") for (int k = 0; k < 2; ++k) dst[m][k] = *(const PG8_LAS bf16x8*)(lds + PG8_SA(b, h) + aoff + m * 2048 + k * 1024); } while (0)
#define PG8_LDB(dst, b, h) do { _Pragma("unroll") for (int n = 0; n < 2; ++n) _Pragma("unroll") for (int k = 0; k < 2; ++k) dst[n][k] = *(const PG8_LAS bf16x8*)(lds + PG8_SB(b, h) + boff + n * 2048 + k * 1024); } while (0)
#define PG8_MMA(ai, bj, At, Bt) do { __builtin_amdgcn_s_setprio(1); _Pragma("unroll") for (int m = 0; m < 4; ++m) _Pragma("unroll") for (int n = 0; n < 2; ++n) _Pragma("unroll") for (int k = 0; k < 2; ++k) \
        acc[ai][bj][m][n] = __builtin_amdgcn_mfma_f32_16x16x32_bf16(Bt[n][k], At[m][k], acc[ai][bj][m][n], 0, 0, 0); __builtin_amdgcn_s_setprio(0); } while (0)
#define PG8_WAIT_V(n) asm volatile("s_waitcnt vmcnt(" #n ")" ::: "memory")
#define PG8_WAIT_L(n) asm volatile("s_waitcnt lgkmcnt(" #n ")" ::: "memory")
#define PG8_BAR __builtin_amdgcn_s_barrier()
#define PG8_SCHED __builtin_amdgcn_sched_barrier(0)
    Unit cur, nxt; int ui = 0;
    if (!S.next(0, cur)) return;
    f32x4 acc[2][2][4][2];
#pragma unroll
    for (int a = 0; a < 2; ++a)
#pragma unroll
        for (int b = 0; b < 2; ++b)
#pragma unroll
            for (int m = 0; m < 4; ++m)
#pragma unroll
                for (int n = 0; n < 2; ++n) acc[a][b][m][n] = (f32x4){0.f, 0.f, 0.f, 0.f};
    bf16x8 At[4][2], B0[2][2], B1[2][2];
    const char* cA = (const char*)g.A + (size_t)cur.pm * tstep; const char* cB = (const char*)g.Bt + (size_t)cur.pn * tstep;
    S.a_ready(cur);
    if constexpr (SP2) {
        PG8_STAGE(PG8_SB(0, 0), cB, voffB); PG8_STAGE(PG8_SB(0, 1), cB + hstep, voffB); PG8_STAGE(PG8_SA(0, 0), cA, voffA); PG8_STAGE(PG8_SA(0, 1), cA + hstep, voffA);
        if (wr == 1) PG8_BAR;
        PG8_WAIT_V(2); PG8_BAR;
        PG8_STAGE(PG8_SB(1, 0), cB + kstep, voffB); PG8_STAGE(PG8_SA(1, 0), cA + kstep, voffA); PG8_STAGE(PG8_SB(1, 1), cB + hstep + kstep, voffB);
        PG8_WAIT_V(6); PG8_BAR;
    } else {
        PG8_STAGE(PG8_SB(0, 0), cB, voffB); PG8_STAGE(PG8_SA(0, 0), cA, voffA); PG8_STAGE(PG8_SB(0, 1), cB + hstep, voffB); PG8_STAGE(PG8_SA(0, 1), cA + hstep, voffA);
        if (wr == 1) PG8_BAR;
        PG8_WAIT_V(4); PG8_BAR;
        PG8_STAGE(PG8_SB(1, 0), cB + kstep, voffB); PG8_STAGE(PG8_SA(1, 0), cA + kstep, voffA); PG8_STAGE(PG8_SB(1, 1), cB + hstep + kstep, voffB);
        PG8_WAIT_V(6); PG8_BAR;
    }
    for (;;) {
        const bool has_next = S.next(ui + 1, nxt);
        const char* nA = has_next ? (const char*)g.A + (size_t)nxt.pm * tstep : cA; const char* nB = has_next ? (const char*)g.Bt + (size_t)nxt.pn * tstep : cB;
        for (int t = 0; t < nt; t += 2) {
            const bool last = (t == nt - 2);
            const char* a1 = cA + (size_t)(t + 1) * kstep;
            const char* a2 = last ? nA : cA + (size_t)(t + 2) * kstep; const char* b2 = last ? nB : cB + (size_t)(t + 2) * kstep;
            const char* a3 = a2 + kstep; const char* b3 = b2 + kstep;
            if (last && has_next) S.a_ready(nxt);
            if constexpr (SP2) {
            PG8_LDB(B0, 0, 0); PG8_LDB(B1, 0, 1); PG8_SCHED; PG8_LDA(At, 0, 0); PG8_STAGE(PG8_SA(1, 1), a1 + hstep, voffA);
            PG8_WAIT_V(8); PG8_WAIT_L(0); PG8_BAR; PG8_MMA(0, 0, At, B0); PG8_MMA(0, 1, At, B1); PG8_BAR; PG8_SCHED;
            PG8_LDA(At, 0, 1); PG8_STAGE(PG8_SB(0, 0), b2, voffB); PG8_STAGE(PG8_SB(0, 1), b2 + hstep, voffB); PG8_STAGE(PG8_SA(0, 0), a2, voffA);
            PG8_WAIT_V(8); PG8_WAIT_L(0); PG8_BAR; PG8_MMA(1, 0, At, B0); PG8_MMA(1, 1, At, B1); PG8_BAR; PG8_SCHED;
            PG8_LDB(B0, 1, 0); PG8_LDB(B1, 1, 1); PG8_SCHED; PG8_LDA(At, 1, 0); PG8_STAGE(PG8_SA(0, 1), a2 + hstep, voffA);
            PG8_WAIT_V(8); PG8_WAIT_L(0); PG8_BAR; PG8_MMA(0, 0, At, B0); PG8_MMA(0, 1, At, B1); PG8_BAR; PG8_SCHED;
            PG8_LDA(At, 1, 1); PG8_STAGE(PG8_SB(1, 0), b3, voffB); PG8_STAGE(PG8_SB(1, 1), b3 + hstep, voffB); PG8_STAGE(PG8_SA(1, 0), a3, voffA);
            PG8_WAIT_V(8); PG8_WAIT_L(0); PG8_BAR; PG8_MMA(1, 0, At, B0); PG8_MMA(1, 1, At, B1); PG8_BAR; PG8_SCHED;
            } else {
            PG8_LDB(B0, 0, 0); PG8_SCHED; PG8_LDA(At, 0, 0); PG8_STAGE(PG8_SA(1, 1), a1 + hstep, voffA);
            PG8_WAIT_L(8); PG8_BAR; PG8_WAIT_L(0); PG8_MMA(0, 0, At, B0); PG8_BAR; PG8_SCHED;
            PG8_LDB(B1, 0, 1); PG8_STAGE(PG8_SB(0, 0), b2, voffB);
            PG8_BAR; PG8_WAIT_L(0); PG8_MMA(0, 1, At, B1); PG8_BAR;
            PG8_LDA(At, 0, 1); PG8_STAGE(PG8_SA(0, 0), a2, voffA);
            PG8_BAR; PG8_WAIT_L(0); PG8_MMA(1, 0, At, B0); PG8_BAR; PG8_SCHED;
            PG8_STAGE(PG8_SB(0, 1), b2 + hstep, voffB);
            PG8_WAIT_V(6); PG8_BAR; PG8_MMA(1, 1, At, B1); PG8_BAR;
            PG8_LDB(B0, 1, 0); PG8_SCHED; PG8_LDA(At, 1, 0); PG8_STAGE(PG8_SA(0, 1), a2 + hstep, voffA);
            PG8_WAIT_L(8); PG8_BAR; PG8_WAIT_L(0); PG8_MMA(0, 0, At, B0); PG8_BAR; PG8_SCHED;
            PG8_LDB(B1, 1, 1); PG8_STAGE(PG8_SB(1, 0), b3, voffB);
            PG8_BAR; PG8_WAIT_L(0); PG8_MMA(0, 1, At, B1); PG8_BAR;
            PG8_LDA(At, 1, 1); PG8_STAGE(PG8_SA(1, 0), a3, voffA);
            PG8_BAR; PG8_WAIT_L(0); PG8_MMA(1, 0, At, B0); PG8_BAR; PG8_SCHED;
            PG8_STAGE(PG8_SB(1, 1), b3 + hstep, voffB);
            PG8_WAIT_V(6); PG8_BAR; PG8_MMA(1, 1, At, B1); PG8_BAR;
            }
        }
        if constexpr (ALIGN_EPI) { if (wr == 0) PG8_BAR; }
        if constexpr (!Epi::AFTER_DRAIN) { E(acc, cur, wr, wc, fr, fq); S.done(cur); }
        if (!has_next) break;
#pragma unroll
        for (int a = 0; a < 2; ++a)
#pragma unroll
            for (int b = 0; b < 2; ++b)
#pragma unroll
                for (int m = 0; m < 4; ++m)
#pragma unroll
                    for (int n = 0; n < 2; ++n) acc[a][b][m][n] = (f32x4){0.f, 0.f, 0.f, 0.f};
        cur = nxt; cA = nA; cB = nB; ++ui;
        if constexpr (ALIGN_EPI) { if (wr == 1) PG8_BAR; }
    }
    PG8_WAIT_V(0);
    if constexpr (!ALIGN_EPI) { if (wr == 0) PG8_BAR; }
    PG8_BAR;
    if constexpr (Epi::AFTER_DRAIN) { E.fused(acc, cur, wr, wc, fr, fq, lds, wid, lane); S.done(cur); }
#undef PG8_SA
#undef PG8_SB
#undef PG8_STAGE
#undef PG8_LDA
#undef PG8_LDB
#undef PG8_MMA
#undef PG8_WAIT_V
#undef PG8_WAIT_L
#undef PG8_BAR
#undef PG8_SCHED
}
}

#define LAS __attribute__((address_space(3)))
typedef unsigned short bf16_t;
typedef short bf16x8 __attribute__((ext_vector_type(8)));
typedef float f32x4 __attribute__((ext_vector_type(4)));
typedef float f32x16 __attribute__((ext_vector_type(16)));
typedef unsigned u32x4 __attribute__((ext_vector_type(4)));
typedef unsigned u32x2 __attribute__((ext_vector_type(2)));
typedef float f32x2_t __attribute__((ext_vector_type(2)));
typedef __bf16 bf16x2_t __attribute__((ext_vector_type(2)));

constexpr int DM = 2048, NB = 4, SEQ = 2048, DEPTH = 4, NMETA = 16;
constexpr int LT = SEQ + NMETA;
constexpr int LP = 2112;
constexpr int MP = NB * LP;
constexpr int INC = 6160, INP = 6400;
constexpr int DFF = 5632, DFF2 = 11264;
constexpr float EPS = 1e-6f;
constexpr int NTHR = 512, NWAVE = 8;
constexpr int LDS_BYTES = 135168;
constexpr int NGLA = 16;

constexpr size_t al256(size_t x) { return (x + 255) & ~(size_t)255; }
constexpr size_t SZ_WIN = (size_t)INP * DM * 2, SZ_WOUT = (size_t)DM * DM * 2, SZ_WUP = (size_t)DFF2 * DM * 2, SZ_WDN = (size_t)DM * DFF * 2;
constexpr size_t WS_WIN = 0;
constexpr size_t WS_WOUT = WS_WIN + DEPTH * SZ_WIN;
constexpr size_t WS_WUP = WS_WOUT + DEPTH * SZ_WOUT;
constexpr size_t WS_WDN = WS_WUP + DEPTH * SZ_WUP;
constexpr size_t WS_X = WS_WDN + DEPTH * SZ_WDN;
constexpr size_t WS_H = WS_X + (size_t)MP * DM * 4;
constexpr size_t WS_P = WS_H + (size_t)MP * DM * 2;
constexpr size_t WS_VTA = WS_P + (size_t)MP * INP * 2;
constexpr size_t WS_VTB = WS_VTA + al256((size_t)NB * 1024 * LP * 2 + 4096);
constexpr size_t WS_OC = WS_VTB + al256((size_t)NB * 1024 * LP * 2 + 4096);
constexpr size_t WS_Y = WS_OC + (size_t)MP * DM * 2;
constexpr size_t WS_U = WS_Y + (size_t)MP * DM * 4;
constexpr size_t WS_G = WS_U + (size_t)MP * DFF2 * 2;
constexpr size_t WS_END = WS_G + (size_t)MP * DFF * 2;

struct Params {
    const float *x, *meta, *pre_mix_g, *w_in, *da_lambda, *da_subln_g, *gate_w2, *gate_b, *gla_norm_g, *w_out, *post_mix_g, *pre_ffn_g, *w_up, *conv_w, *conv_b, *w_down, *post_ffn_g;
    float* out; unsigned char* ws; int ph_lo, ph_hi;
};

__device__ __forceinline__ unsigned pack2(float lo, float hi) { f32x2_t v = {lo, hi}; bf16x2_t b = __builtin_convertvector(v, bf16x2_t); return __builtin_bit_cast(unsigned, b); }
__device__ __forceinline__ float bf2f(unsigned short u) { return __uint_as_float(((unsigned)u) << 16); }
__device__ __forceinline__ float bflo(unsigned u) { return __uint_as_float(u << 16); }
__device__ __forceinline__ float bfhi(unsigned u) { return __uint_as_float(u & 0xffff0000u); }
__device__ __forceinline__ float wave_sum(float v) {
#pragma unroll
    for (int o = 1; o < 64; o <<= 1) v += __shfl_xor(v, o);
    return v;
}
#define MFMA32(a, b, c) __builtin_amdgcn_mfma_f32_32x32x16_bf16((a), (b), (c), 0, 0, 0)
__device__ __forceinline__ bf16x8 pack8(const f32x16& x, int s) {
    u32x4 p; p.x = pack2(x[8 * s + 0], x[8 * s + 1]); p.y = pack2(x[8 * s + 2], x[8 * s + 3]); p.z = pack2(x[8 * s + 4], x[8 * s + 5]); p.w = pack2(x[8 * s + 6], x[8 * s + 7]);
    return __builtin_bit_cast(bf16x8, p);
}
__device__ __forceinline__ int swap23(int i) { return (i & ~12) | ((i & 4) << 1) | ((i & 8) >> 1); }
__device__ __forceinline__ int crow(int r, int hi) { return (r & 3) + 8 * (r >> 2) + 4 * hi; }

__device__ __forceinline__ void transpose_item(const float* W, int K, int Nsrc, bf16_t* WT, LAS float* scr, int item, int nblk, int lane) {
    const int kb = item / nblk, nb = item - kb * nblk, k0 = 64 * kb, n0 = 32 * nb;
    const int n = n0 + (lane & 31); const bool ok = n < Nsrc;
#pragma unroll 8
    for (int i = 0; i < 32; ++i) { const int kk = 2 * i + (lane >> 5); scr[kk * 33 + (lane & 31)] = ok ? W[(size_t)(k0 + kk) * Nsrc + n] : 0.f; }
    asm volatile("s_waitcnt lgkmcnt(0)" ::: "memory");
    const int c = lane & 7;
#pragma unroll
    for (int j = 0; j < 4; ++j) { const int nn = (lane >> 3) + 8 * j; const LAS float* s = scr + (8 * c) * 33 + nn;
        u32x4 o; o.x = pack2(s[0 * 33], s[1 * 33]); o.y = pack2(s[2 * 33], s[3 * 33]); o.z = pack2(s[4 * 33], s[5 * 33]); o.w = pack2(s[6 * 33], s[7 * 33]);
        *(u32x4*)(WT + (size_t)(n0 + nn) * K + k0 + 8 * c) = o; }
    asm volatile("s_waitcnt lgkmcnt(0)" ::: "memory");
}

template <int MODE>
__device__ __forceinline__ void row_phase(const float* xin, const float* meta, float* outp, float* X, const float* Y, bf16_t* H, const float* g1, const float* g2, int gw, int ngw, int lane) {
    for (int row = gw; row < MP; row += ngw) {
        const int b = row / LP, t = row - b * LP;
        f32x4 xv[8];
        float* xr = X + (size_t)row * DM;
        if (MODE == 0) {
            const float* src = (t < NMETA) ? meta + (size_t)t * DM : xin + ((size_t)b * SEQ + (t - NMETA)) * DM;
#pragma unroll
            for (int j = 0; j < 8; ++j) xv[j] = (t < LT) ? *(const f32x4*)(src + 4 * (lane + 64 * j)) : (f32x4){0.f, 0.f, 0.f, 0.f};
        } else {
            const float* yr = Y + (size_t)row * DM;
            f32x4 yv[8]; float ss = 0.f;
#pragma unroll
            for (int j = 0; j < 8; ++j) { yv[j] = *(const f32x4*)(yr + 4 * (lane + 64 * j)); ss += (yv[j].x * yv[j].x + yv[j].y * yv[j].y) + (yv[j].z * yv[j].z + yv[j].w * yv[j].w); }
            const float r1 = rsqrtf(wave_sum(ss) * (1.f / DM) + EPS);
#pragma unroll
            for (int j = 0; j < 8; ++j) { const f32x4 g = *(const f32x4*)(g1 + 4 * (lane + 64 * j)); const f32x4 xo = *(const f32x4*)(xr + 4 * (lane + 64 * j)); xv[j] = xo + yv[j] * r1 * g; }
        }
        if (MODE == 2) {
            if (t >= NMETA && t < LT) { float* orow = outp + ((size_t)b * SEQ + (t - NMETA)) * DM;
#pragma unroll
                for (int j = 0; j < 8; ++j) *(f32x4*)(orow + 4 * (lane + 64 * j)) = xv[j]; }
        } else {
            float ss = 0.f;
#pragma unroll
            for (int j = 0; j < 8; ++j) { *(f32x4*)(xr + 4 * (lane + 64 * j)) = xv[j]; ss += (xv[j].x * xv[j].x + xv[j].y * xv[j].y) + (xv[j].z * xv[j].z + xv[j].w * xv[j].w); }
            const float r2 = rsqrtf(wave_sum(ss) * (1.f / DM) + EPS);
            bf16_t* hr = H + (size_t)row * DM;
#pragma unroll
            for (int j = 0; j < 8; ++j) { const f32x4 g = *(const f32x4*)(g2 + 4 * (lane + 64 * j)); const f32x4 v = xv[j] * r2 * g;
                u32x2 w; w.x = pack2(v.x, v.y); w.y = pack2(v.z, v.w); *(u32x2*)(hr + 4 * (lane + 64 * j)) = w; }
        }
    }
}

__device__ __forceinline__ void conv_phase(const bf16_t* U, bf16_t* G, const float* cw, const float* cb, int gtid, int ngt) {
    constexpr int NCG = DFF / 8, NSTRIP = MP / 16;
    for (int it = gtid; it < NCG * NSTRIP; it += ngt) {
        const int s = it / NCG, cgp = it - s * NCG, j0 = 8 * cgp, row0 = 16 * s; const int t0 = row0 % LP;
        float wa[3][8], wv[3][8], ba[8], bv[8];
#pragma unroll
        for (int i = 0; i < 3; ++i)
#pragma unroll
            for (int e = 0; e < 8; e += 4) { const f32x4 a = *(const f32x4*)(cw + (size_t)i * DFF2 + j0 + e), v = *(const f32x4*)(cw + (size_t)i * DFF2 + DFF + j0 + e);
                wa[i][e] = a.x; wa[i][e + 1] = a.y; wa[i][e + 2] = a.z; wa[i][e + 3] = a.w; wv[i][e] = v.x; wv[i][e + 1] = v.y; wv[i][e + 2] = v.z; wv[i][e + 3] = v.w; }
#pragma unroll
        for (int e = 0; e < 8; e += 4) { const f32x4 a = *(const f32x4*)(cb + j0 + e), v = *(const f32x4*)(cb + DFF + j0 + e);
            ba[e] = a.x; ba[e + 1] = a.y; ba[e + 2] = a.z; ba[e + 3] = a.w; bv[e] = v.x; bv[e + 1] = v.y; bv[e + 2] = v.z; bv[e + 3] = v.w; }
        u32x4 a2 = {0, 0, 0, 0}, a1 = {0, 0, 0, 0}, v2 = {0, 0, 0, 0}, v1 = {0, 0, 0, 0};
        if (t0 > 0) { const bf16_t* u = U + (size_t)(row0 - 2) * DFF2 + j0; a2 = *(const u32x4*)u; v2 = *(const u32x4*)(u + DFF); a1 = *(const u32x4*)(u + DFF2); v1 = *(const u32x4*)(u + DFF2 + DFF); }
#pragma unroll 4
        for (int r = 0; r < 16; ++r) {
            const bf16_t* u = U + (size_t)(row0 + r) * DFF2 + j0;
            const u32x4 a0 = *(const u32x4*)u, v0 = *(const u32x4*)(u + DFF);
            unsigned ow[4];
#pragma unroll
            for (int q = 0; q < 4; ++q) {
                const float al = ba[2 * q] + wa[0][2 * q] * bflo(a2[q]) + wa[1][2 * q] * bflo(a1[q]) + wa[2][2 * q] * bflo(a0[q]);
                const float ah = ba[2 * q + 1] + wa[0][2 * q + 1] * bfhi(a2[q]) + wa[1][2 * q + 1] * bfhi(a1[q]) + wa[2][2 * q + 1] * bfhi(a0[q]);
                const float vl = bv[2 * q] + wv[0][2 * q] * bflo(v2[q]) + wv[1][2 * q] * bflo(v1[q]) + wv[2][2 * q] * bflo(v0[q]);
                const float vh = bv[2 * q + 1] + wv[0][2 * q + 1] * bfhi(v2[q]) + wv[1][2 * q + 1] * bfhi(v1[q]) + wv[2][2 * q + 1] * bfhi(v0[q]);
                const float gl = al / (1.f + __expf(-al)) * vl, gh = ah / (1.f + __expf(-ah)) * vh;
                ow[q] = pack2(gl, gh);
            }
            *(u32x4*)(G + (size_t)(row0 + r) * DFF + j0) = (u32x4){ow[0], ow[1], ow[2], ow[3]};
            a2 = a1; a1 = a0; v2 = v1; v1 = v0;
        }
    }
}

constexpr int AT_KSTR = 144, AT_K1 = 64 * AT_KSTR  , AT_VOFF = 2 * AT_K1  , AT_BUF = AT_VOFF + 128 * AT_KSTR  ;
__device__ __forceinline__ void attn_unit(unsigned char* lds, const bf16_t* __restrict__ P, const bf16_t* __restrict__ Vt, bf16_t* __restrict__ OC, const float* subg_lds,
                                          int b, int h, int qt, float lam, float omli) {
    int tid_ = threadIdx.x; asm volatile("" : "+v"(tid_));
    const int tid = tid_, lane = tid & 63, w = __builtin_amdgcn_readfirstlane(tid >> 6), l31 = lane & 31, hi = lane >> 5;
    const int c = w >> 2, qb = w & 3;
    const int nkt = (2 * qt + 2 < 33) ? 2 * qt + 2 : 33;
    const int qrow0 = 128 * qt + 32 * qb;
    const bool active = qrow0 < LP;
    bf16x8 qf[4];
    {
        const bf16_t* qp = P + (size_t)(b * LP + (active ? qrow0 : 0) + l31) * INP + h * 128 + c * 64 + hi * 8;
#pragma unroll
        for (int ks = 0; ks < 4; ++ks) qf[ks] = *(const bf16x8*)(qp + 16 * ks);
    }
    f32x16 O[4];
#pragma unroll
    for (int v = 0; v < 4; ++v)
#pragma unroll
        for (int r = 0; r < 16; ++r) O[v][r] = 0.f;
    float m = -INFINITY, l = 0.f;
    const bf16_t* kbase = P + (size_t)(b * LP) * INP + 1024 + h * 128;
    const bf16_t* vbase = Vt + (size_t)(b * 1024 + h * 128) * LP;
    const int kkey0 = tid >> 4, kch = tid & 15;
    const int vdv0 = tid >> 3, vch = tid & 7;
    const bf16_t* ksrc = kbase + (size_t)kkey0 * INP + kch * 8;
    const bf16_t* vsrc = vbase + (size_t)vdv0 * LP + vch * 8;
    const int kdst = (kch >> 3) * AT_K1 + kkey0 * AT_KSTR + (kch & 7) * 16;
    const int vdst = AT_VOFF + vdv0 * AT_KSTR + vch * 16;
    u32x4 tk0, tk1, tv0, tv1;
#define AT_LOAD(kt) do { const bf16_t* ks_ = ksrc + (size_t)(64 * (kt)) * INP; tk0 = *(const u32x4*)ks_; tk1 = *(const u32x4*)(ks_ + (size_t)32 * INP); \
        const bf16_t* vs_ = vsrc + 64 * (kt); tv0 = *(const u32x4*)vs_; tv1 = *(const u32x4*)(vs_ + (size_t)64 * LP); } while (0)
#define AT_STORE(buf) do { unsigned char* d_ = lds + (buf) * AT_BUF; *(u32x4*)(d_ + kdst) = tk0; *(u32x4*)(d_ + kdst + 32 * AT_KSTR) = tk1; \
        *(u32x4*)(d_ + vdst) = tv0; *(u32x4*)(d_ + vdst + 64 * AT_KSTR) = tv1; } while (0)
    AT_LOAD(0); AT_STORE(0);
    __syncthreads();
    const int krow_off = c * AT_K1 + swap23(l31) * AT_KSTR + hi * 16;
    const int vrow_off = AT_VOFF + l31 * AT_KSTR + hi * 16;
    for (int kt = 0; kt < nkt; ++kt) {
        const bool more = kt + 1 < nkt;
        if (more) AT_LOAD(kt + 1);
        const unsigned char* buf = lds + (kt & 1) * AT_BUF;
        if (active && 64 * kt <= qrow0 + 31) {
            f32x16 s0, s1;
#pragma unroll
            for (int r = 0; r < 16; ++r) { s0[r] = 0.f; s1[r] = 0.f; }
#pragma unroll
            for (int ks = 0; ks < 4; ++ks) {
                const bf16x8 k0 = *(const bf16x8*)(buf + krow_off + ks * 32), k1 = *(const bf16x8*)(buf + krow_off + 32 * AT_KSTR + ks * 32);
                s0 = MFMA32(k0, qf[ks], s0); s1 = MFMA32(k1, qf[ks], s1);
            }
            if (64 * kt + 63 > qrow0) {
                const int q = qrow0 + l31, kb0 = 64 * kt + 8 * hi;
#pragma unroll
                for (int r = 0; r < 16; ++r) { const int key = kb0 + 16 * (r >> 3) + (r & 7); if (key > q) s0[r] = -INFINITY; if (key + 32 > q) s1[r] = -INFINITY; }
            }
            float mx = fmaxf(s0[0], s1[0]);
#pragma unroll
            for (int r = 1; r < 16; ++r) mx = fmaxf(mx, fmaxf(s0[r], s1[r]));
            mx = fmaxf(mx, __shfl_xor(mx, 32));
            const float mn = fmaxf(m, mx), alpha = __builtin_amdgcn_exp2f(m - mn);
            m = mn;
            float sum = 0.f;
#pragma unroll
            for (int r = 0; r < 16; ++r) { s0[r] = __builtin_amdgcn_exp2f(s0[r] - mn); s1[r] = __builtin_amdgcn_exp2f(s1[r] - mn); sum += s0[r] + s1[r]; }
            l = l * alpha + sum;
#pragma unroll
            for (int v = 0; v < 4; ++v)
#pragma unroll
                for (int r = 0; r < 16; ++r) O[v][r] *= alpha;
            const bf16x8 p00 = pack8(s0, 0), p01 = pack8(s0, 1), p10 = pack8(s1, 0), p11 = pack8(s1, 1);
#pragma unroll
            for (int v = 0; v < 4; ++v) {
                const unsigned char* vp = buf + vrow_off + v * 32 * AT_KSTR;
                const bf16x8 a0 = *(const bf16x8*)(vp), a1 = *(const bf16x8*)(vp + 32), a2 = *(const bf16x8*)(vp + 64), a3 = *(const bf16x8*)(vp + 96);
                O[v] = MFMA32(a0, p00, O[v]); O[v] = MFMA32(a1, p01, O[v]); O[v] = MFMA32(a2, p10, O[v]); O[v] = MFMA32(a3, p11, O[v]);
            }
        }
        if (more) AT_STORE((kt + 1) & 1);
        __syncthreads();
    }
#undef AT_LOAD
#undef AT_STORE
    l += __shfl_xor(l, 32);
    const float inv = 1.f / l;
    float* ex = (float*)lds + (size_t)qb * 4096;
    if (c == 1 && active) {
#pragma unroll
        for (int v = 0; v < 4; ++v)
#pragma unroll
            for (int r = 0; r < 16; ++r) ex[(v * 16 + r) * 64 + lane] = O[v][r] * inv;
    }
    __syncthreads();
    if (c == 0 && active) {
        float ss = 0.f;
#pragma unroll
        for (int v = 0; v < 4; ++v)
#pragma unroll
            for (int r = 0; r < 16; ++r) { const float o = O[v][r] * inv - lam * ex[(v * 16 + r) * 64 + lane]; O[v][r] = o; ss += o * o; }
        ss += __shfl_xor(ss, 32);
        const float rs = rsqrtf(ss * (1.f / 128.f) + EPS) * omli;
        bf16_t* orow = OC + (size_t)(b * LP + qrow0 + l31) * DM + h * 128;
#pragma unroll
        for (int v = 0; v < 4; ++v)
#pragma unroll
            for (int r4 = 0; r4 < 4; ++r4) { const int dv = 32 * v + 8 * r4 + 4 * hi; const f32x4 g = *(const f32x4*)(subg_lds + dv);
                u32x2 wv; wv.x = pack2(O[v][4 * r4] * rs * g.x, O[v][4 * r4 + 1] * rs * g.y); wv.y = pack2(O[v][4 * r4 + 2] * rs * g.z, O[v][4 * r4 + 3] * rs * g.w);
                *(u32x2*)(orow + dv) = wv; }
    }
    __syncthreads();
}

constexpr int GL_QSTR = 272, GL_TSTR = 144;
constexpr int GL_QIN = 0, GL_KIN = 64 * GL_QSTR  , GL_KOUT = 2 * 64 * GL_QSTR  , GL_VT = GL_KOUT + 128 * GL_TSTR  , GL_LR = GL_VT + 256 * GL_TSTR  ,
              GL_SEG = GL_LR + 4096, GL_DEC = GL_SEG + 2048, GL_NG = GL_DEC + 512, GL_RAWQ = GL_NG + 1024  , GL_RAWK = GL_RAWQ + 16384, GL_END = GL_RAWK + 16384  ;
constexpr int GL_OSTR = 260;
__device__ __forceinline__ void gla_unit(unsigned char* lds, const bf16_t* __restrict__ P, const bf16_t* __restrict__ Vt, bf16_t* __restrict__ OC,
                                         const float* __restrict__ w2, const float* __restrict__ b2, const float* __restrict__ ng, int b, int h) {
    int tid_ = threadIdx.x; asm volatile("" : "+v"(tid_));
    const int tid = tid_, lane = tid & 63, w = __builtin_amdgcn_readfirstlane(tid >> 6), l31 = lane & 31, hi = lane >> 5;
    const int d = tid & 127, seg = tid >> 7;
    float w2r[16];
#pragma unroll
    for (int j = 0; j < 16; ++j) w2r[j] = w2[(size_t)j * 512 + h * 128 + d];
    const float b2r = b2[h * 128 + d];
    float* LR = (float*)(lds + GL_LR); float* SEG = (float*)(lds + GL_SEG); float* DEC = (float*)(lds + GL_DEC); float* NG = (float*)(lds + GL_NG);
    if (tid < 256) NG[tid] = ng[tid];
    f32x16 S[4];
#pragma unroll
    for (int k = 0; k < 4; ++k)
#pragma unroll
        for (int r = 0; r < 16; ++r) S[k][r] = 0.f;
    const int dpos = swap23(d);
    const int tok8 = tid >> 3, part = tid & 7;
    for (int n = 0; n < LP / 64; ++n) {
        const size_t R0 = (size_t)b * LP + 64 * n;
        const unsigned lrw = *(const unsigned*)(P + (R0 + tok8) * INP + 6144 + 2 * part);
        {
          const bf16_t* qp = P + (R0 + (tid >> 4)) * INP + 3072 + h * 128 + (tid & 15) * 8;
          const u32x4 q0 = *(const u32x4*)qp, q1 = *(const u32x4*)(qp + (size_t)32 * INP), k0 = *(const u32x4*)(qp + 512), k1 = *(const u32x4*)(qp + (size_t)32 * INP + 512);
          unsigned char* rq = lds + GL_RAWQ + (tid >> 4) * 256 + (tid & 15) * 16;
          *(u32x4*)rq = q0; *(u32x4*)(rq + 32 * 256) = q1; *(u32x4*)(rq + 16384) = k0; *(u32x4*)(rq + 16384 + 32 * 256) = k1; }
        u32x4 vt[4];
        { const bf16_t* vp = Vt + ((size_t)b * 1024 + h * 256 + (tid >> 3)) * LP + 64 * n + (tid & 7) * 8;
#pragma unroll
          for (int i = 0; i < 4; ++i) vt[i] = *(const u32x4*)(vp + (size_t)(64 * i) * LP); }
        LR[tok8 * 16 + 2 * part] = bflo(lrw); LR[tok8 * 16 + 2 * part + 1] = bfhi(lrw);
        __syncthreads();
        float bc[16]; float run = 0.f;
#pragma unroll
        for (int i = 0; i < 16; ++i) {
            const float* lr = LR + (16 * seg + i) * 16; float z = b2r;
#pragma unroll
            for (int j = 0; j < 16; j += 4) { const f32x4 v = *(const f32x4*)(lr + j); z += v.x * w2r[j] + v.y * w2r[j + 1] + v.z * w2r[j + 2] + v.w * w2r[j + 3]; }
            const float ls = fminf(z, 0.f) - __logf(1.f + __expf(-fabsf(z)));
            run += ls * (1.f / 16.f); bc[i] = run;
        }
        SEG[seg * 128 + d] = run;
        __syncthreads();
        float off = 0.f, tot = 0.f;
#pragma unroll
        for (int s = 0; s < 4; ++s) { const float v = SEG[s * 128 + d]; tot += v; if (s < seg) off += v; }
        if (seg == 0) DEC[d] = __expf(tot);
        {
            unsigned ko[8];
#pragma unroll
            for (int i = 0; i < 16; i += 2) {
                const float b0 = bc[i] + off, b1 = bc[i + 1] + off;
                const bf16_t* rq = (const bf16_t*)(lds + GL_RAWQ + (16 * seg + i) * 256) + d;
                const float q0 = bf2f(rq[0]) * __expf(b0) * 0.08838834764831845f, q1 = bf2f(rq[128]) * __expf(b1) * 0.08838834764831845f;
                const float k0 = bf2f(rq[8192]), k1 = bf2f(rq[8192 + 128]);
                const unsigned qq = pack2(q0, q1), kk = pack2(k0 * __expf(-b0), k1 * __expf(-b1));
                bf16_t* qd = (bf16_t*)(lds + GL_QIN + (16 * seg + i) * GL_QSTR) + dpos; bf16_t* kd = (bf16_t*)(lds + GL_KIN + (16 * seg + i) * GL_QSTR) + dpos;
                qd[0] = (bf16_t)(qq & 0xffffu); qd[GL_QSTR / 2] = (bf16_t)(qq >> 16); kd[0] = (bf16_t)(kk & 0xffffu); kd[GL_QSTR / 2] = (bf16_t)(kk >> 16);
                ko[i >> 1] = pack2(k0 * __expf(tot - b0), k1 * __expf(tot - b1));
            }
            unsigned char* kod = lds + GL_KOUT + d * GL_TSTR + seg * 32;
            *(u32x4*)kod = (u32x4){ko[0], ko[1], ko[2], ko[3]}; *(u32x4*)(kod + 16) = (u32x4){ko[4], ko[5], ko[6], ko[7]};
#pragma unroll
            for (int i = 0; i < 4; ++i) *(u32x4*)(lds + GL_VT + ((tid >> 3) + 64 * i) * GL_TSTR + (tid & 7) * 16) = vt[i];
        }
        __syncthreads();
        f32x16 X00, X01, X11;
#pragma unroll
        for (int r = 0; r < 16; ++r) { X00[r] = 0.f; X01[r] = 0.f; X11[r] = 0.f; }
        {
            const unsigned char* ka = lds + GL_KIN + swap23(l31) * GL_QSTR + hi * 16;
            const unsigned char* qa = lds + GL_QIN + l31 * GL_QSTR + hi * 16;
#pragma unroll 2
            for (int ks = 0; ks < 8; ++ks) {
                const bf16x8 k0 = *(const bf16x8*)(ka + ks * 32), k1 = *(const bf16x8*)(ka + 32 * GL_QSTR + ks * 32);
                const bf16x8 q0 = *(const bf16x8*)(qa + ks * 32), q1 = *(const bf16x8*)(qa + 32 * GL_QSTR + ks * 32);
                X00 = MFMA32(k0, q0, X00); X01 = MFMA32(k0, q1, X01); X11 = MFMA32(k1, q1, X11);
            }
#pragma unroll
            for (int r = 0; r < 16; ++r) { const int j = 16 * (r >> 3) + 8 * hi + (r & 7); if (j > l31) { X00[r] = 0.f; X11[r] = 0.f; } }
        }
        f32x16 Oa, Ob; u32x4 go[4];
#pragma unroll
        for (int r = 0; r < 16; ++r) { Oa[r] = 0.f; Ob[r] = 0.f; }
        {
            const unsigned char* va = lds + GL_VT + (32 * w + l31) * GL_TSTR + hi * 16;
            const bf16x8 v0 = *(const bf16x8*)(va), v1 = *(const bf16x8*)(va + 32), v2 = *(const bf16x8*)(va + 64), v3 = *(const bf16x8*)(va + 96);
            Oa = MFMA32(pack8(X00, 0), v0, Oa); Oa = MFMA32(pack8(X00, 1), v1, Oa);
            Ob = MFMA32(pack8(X01, 0), v0, Ob); Ob = MFMA32(pack8(X01, 1), v1, Ob);
            Ob = MFMA32(pack8(X11, 0), v2, Ob); Ob = MFMA32(pack8(X11, 1), v3, Ob);
            const unsigned char* qa = lds + GL_QIN + l31 * GL_QSTR + hi * 16;
#pragma unroll
            for (int kb = 0; kb < 4; ++kb)
#pragma unroll
                for (int s = 0; s < 2; ++s) {
                    const bf16x8 sb = pack8(S[kb], s);
                    const bf16x8 q0 = *(const bf16x8*)(qa + kb * 64 + s * 32), q1 = *(const bf16x8*)(qa + 32 * GL_QSTR + kb * 64 + s * 32);
                    Oa = MFMA32(q0, sb, Oa); Ob = MFMA32(q1, sb, Ob);
                }
            { const bf16_t* gp = P + (R0 + tok8) * INP + 5120 + h * 256 + 32 * part;
#pragma unroll
              for (int i = 0; i < 4; ++i) go[i] = *(const u32x4*)(gp + 8 * i); }
#pragma unroll
            for (int kb = 0; kb < 4; ++kb) {
#pragma unroll
                for (int r4 = 0; r4 < 4; ++r4) { const f32x4 dc = *(const f32x4*)(DEC + 32 * kb + 8 * r4 + 4 * hi);
                    S[kb][4 * r4] *= dc.x; S[kb][4 * r4 + 1] *= dc.y; S[kb][4 * r4 + 2] *= dc.z; S[kb][4 * r4 + 3] *= dc.w; }
                const unsigned char* ko = lds + GL_KOUT + (32 * kb + l31) * GL_TSTR + hi * 16;
                S[kb] = MFMA32(*(const bf16x8*)(ko), v0, S[kb]); S[kb] = MFMA32(*(const bf16x8*)(ko + 32), v1, S[kb]);
                S[kb] = MFMA32(*(const bf16x8*)(ko + 64), v2, S[kb]); S[kb] = MFMA32(*(const bf16x8*)(ko + 96), v3, S[kb]);
            }
        }
        __syncthreads();
        {
            float* ost = (float*)lds;
#pragma unroll
            for (int r = 0; r < 16; ++r) { ost[crow(r, hi) * GL_OSTR + 32 * w + l31] = Oa[r]; ost[(32 + crow(r, hi)) * GL_OSTR + 32 * w + l31] = Ob[r]; }
        }
        __syncthreads();
        {
            const float* orow = (const float*)lds + tok8 * GL_OSTR + 32 * part;
            f32x4 ov[8]; float ss = 0.f;
#pragma unroll
            for (int i = 0; i < 8; ++i) { ov[i] = *(const f32x4*)(orow + 4 * i); ss += (ov[i].x * ov[i].x + ov[i].y * ov[i].y) + (ov[i].z * ov[i].z + ov[i].w * ov[i].w); }
            ss += __shfl_xor(ss, 1); ss += __shfl_xor(ss, 2); ss += __shfl_xor(ss, 4);
            const float rs = rsqrtf(ss * (1.f / 256.f) + EPS);
            bf16_t* od = OC + (R0 + tok8) * DM + 1024 + h * 256 + 32 * part;
#pragma unroll
            for (int i = 0; i < 4; ++i) {
                unsigned ow[4];
#pragma unroll
                for (int q = 0; q < 4; ++q) {
                    const int e = 8 * i + 2 * q; const f32x4 o4 = ov[e >> 2]; const float o0 = (e & 2) ? o4.z : o4.x, o1 = (e & 2) ? o4.w : o4.y;
                    const float g0 = bflo(go[i][q]), g1 = bfhi(go[i][q]);
                    ow[q] = pack2(o0 * rs * NG[32 * part + e] * (g0 / (1.f + __expf(-g0))), o1 * rs * NG[32 * part + e + 1] * (g1 / (1.f + __expf(-g1))));
                }
                *(u32x4*)(od + 8 * i) = (u32x4){ow[0], ow[1], ow[2], ow[3]};
            }
        }
    }
    __syncthreads();
}

constexpr int PTAB = 131072;
enum { T_X = 0, T_META, T_PRE_MIX_G, T_W_IN, T_DA_LAMBDA, T_DA_SUBLN_G, T_GATE_W2, T_GATE_B, T_GLA_NORM_G, T_W_OUT, T_POST_MIX_G, T_PRE_FFN_G, T_W_UP, T_CONV_W, T_CONV_B, T_W_DOWN, T_POST_FFN_G, T_OUT, T_WS, T_N };
__device__ __forceinline__ unsigned long long ldp_(const unsigned char* lds, int i) {
    const unsigned long long v = ((const volatile unsigned long long*)(lds + PTAB))[i];
    const unsigned lo = __builtin_amdgcn_readfirstlane((unsigned)v), hi = __builtin_amdgcn_readfirstlane((unsigned)(v >> 32));
    return ((unsigned long long)hi << 32) | lo;
}
#define LDF(i) ((const float*)ldp_(lds, (i)))
#define LDWS() ((unsigned char*)ldp_(lds, T_WS))
__global__ void __launch_bounds__(NTHR) hymba_fwd(Params p) {
    extern __shared__ __attribute__((aligned(16))) unsigned char lds[];
    cg::grid_group grid = cg::this_grid();
    if (threadIdx.x == 0) {
        unsigned long long* tab = (unsigned long long*)(lds + PTAB);
        tab[T_X] = (unsigned long long)p.x; tab[T_META] = (unsigned long long)p.meta; tab[T_PRE_MIX_G] = (unsigned long long)p.pre_mix_g; tab[T_W_IN] = (unsigned long long)p.w_in;
        tab[T_DA_LAMBDA] = (unsigned long long)p.da_lambda; tab[T_DA_SUBLN_G] = (unsigned long long)p.da_subln_g; tab[T_GATE_W2] = (unsigned long long)p.gate_w2; tab[T_GATE_B] = (unsigned long long)p.gate_b;
        tab[T_GLA_NORM_G] = (unsigned long long)p.gla_norm_g; tab[T_W_OUT] = (unsigned long long)p.w_out; tab[T_POST_MIX_G] = (unsigned long long)p.post_mix_g; tab[T_PRE_FFN_G] = (unsigned long long)p.pre_ffn_g;
        tab[T_W_UP] = (unsigned long long)p.w_up; tab[T_CONV_W] = (unsigned long long)p.conv_w; tab[T_CONV_B] = (unsigned long long)p.conv_b; tab[T_W_DOWN] = (unsigned long long)p.w_down;
        tab[T_POST_FFN_G] = (unsigned long long)p.post_ffn_g; tab[T_OUT] = (unsigned long long)p.out; tab[T_WS] = (unsigned long long)p.ws;
    }
    __syncthreads();
    const int lo = p.ph_lo, hi_ = p.ph_hi; const bool multi = (hi_ - lo) > 1;
    int ph = 0;
#define IN_PH() (ph >= lo && ph < hi_)
#define SEAM() do { ++ph; if (multi) grid.sync(); } while (0)
#define PH_VARS() int tid_ = threadIdx.x; asm volatile("" : "+v"(tid_)); int bx = blockIdx.x; asm volatile("" : "+s"(bx)); const int G = gridDim.x; \
    const int tid = tid_, lane = tid & 63, wave = __builtin_amdgcn_readfirstlane(tid >> 6); const int gw = bx * NWAVE + wave, ngw = G * NWAVE; \
    unsigned char* ws = LDWS(); LAS unsigned char* ldsa = (LAS unsigned char*)lds; (void)lane; (void)gw; (void)ngw; (void)ldsa; (void)ws

#ifndef NO_PRO
    if (IN_PH()) {
        PH_VARS();
        LAS float* scr = (LAS float*)(ldsa + wave * 16384);
        constexpr int NB_IN = INP / 32, NB_D = DM / 32, NB_UP = DFF2 / 32;
        constexpr int I_IN = (DM / 64) * NB_IN, I_OUT = (DM / 64) * NB_D, I_UP = (DM / 64) * NB_UP, I_DN = (DFF / 64) * NB_D, I_L = I_IN + I_OUT + I_UP + I_DN;
        for (int it = gw; it < DEPTH * I_L; it += ngw) {
            const int l = it / I_L; int r = it - l * I_L;
            if (r < I_IN) { transpose_item(LDF(T_W_IN) + (size_t)l * DM * INC, DM, INC, (bf16_t*)(ws + WS_WIN) + (size_t)l * INP * DM, scr, r, NB_IN, lane); continue; } r -= I_IN;
            if (r < I_OUT) { transpose_item(LDF(T_W_OUT) + (size_t)l * DM * DM, DM, DM, (bf16_t*)(ws + WS_WOUT) + (size_t)l * DM * DM, scr, r, NB_D, lane); continue; } r -= I_OUT;
            if (r < I_UP) { transpose_item(LDF(T_W_UP) + (size_t)l * DM * DFF2, DM, DFF2, (bf16_t*)(ws + WS_WUP) + (size_t)l * DFF2 * DM, scr, r, NB_UP, lane); continue; } r -= I_UP;
            transpose_item(LDF(T_W_DOWN) + (size_t)l * DFF * DM, DFF, DM, (bf16_t*)(ws + WS_WDN) + (size_t)l * DM * DFF, scr, r, NB_D, lane);
        }
        row_phase<0>(LDF(T_X), LDF(T_META), nullptr, (float*)(ws + WS_X), nullptr, (bf16_t*)(ws + WS_H), nullptr, LDF(T_PRE_MIX_G), gw, ngw, lane);
    }
#endif
    SEAM();

    for (int l = 0; l < DEPTH; ++l) {
        if (IN_PH()) {
            PH_VARS();
            pg8::Gemm g{(bf16_t*)(ws + WS_H), (bf16_t*)(ws + WS_WIN) + (size_t)l * INP * DM, MP, INP, DM}; pg8::StaticOrder S; S.init(MP, INP, G, bx);
            pg8::EpiIn E{(bf16_t*)(ws + WS_P), INP, (bf16_t*)(ws + WS_VTA), (bf16_t*)(ws + WS_VTB), LP, 0.125f * 1.4426950408889634f};
#ifndef NO_G1
            pg8::gemm_phase<pg8::EpiIn, pg8::StaticOrder, true, true>(ldsa, g, S, E);
#endif
        }
        SEAM();
        if (IN_PH()) {
            PH_VARS();
            const bf16_t* P = (const bf16_t*)(ws + WS_P); bf16_t* OC = (bf16_t*)(ws + WS_OC);
            if (bx < NGLA) {
#ifndef NO_GLA
                gla_unit(lds, P, (const bf16_t*)(ws + WS_VTB), OC, LDF(T_GATE_W2) + (size_t)l * 16 * 512, LDF(T_GATE_B) + (size_t)l * 512, LDF(T_GLA_NORM_G) + (size_t)l * 256, bx >> 2, bx & 3);
#endif
            } else {
                float* subg = (float*)(lds + 80000); float* lamw = subg + 128;
                const float lam_init = 0.8f - 0.6f * __expf(-0.3f * (float)l);
                if (tid < 128) subg[tid] = LDF(T_DA_SUBLN_G)[(size_t)l * 128 + tid];
                if (wave == 0) { const float* lv = LDF(T_DA_LAMBDA) + (size_t)l * 256; const float a = wave_sum(lv[lane] * lv[64 + lane]), c2 = wave_sum(lv[128 + lane] * lv[192 + lane]);
                    if (lane == 0) lamw[0] = __expf(a) - __expf(c2) + lam_init; }
                __syncthreads();
                const float lam = lamw[0];
                const int Ga = G - NGLA, ai = bx - NGLA;
                for (int k = 0; k * Ga < 544; ++k) {
                    const int j = k * Ga + ((k & 1) ? (Ga - 1 - ai) : ai);
#ifndef NO_ATTN
                    if (j < 544) attn_unit(lds, P, (const bf16_t*)(ws + WS_VTA), OC, subg, (j & 31) >> 3, j & 7, 16 - (j >> 5), lam, 1.f - lam_init);
#endif
                }
            }
        }
        SEAM();
        if (IN_PH()) {
            PH_VARS();
            pg8::Gemm g{(bf16_t*)(ws + WS_OC), (bf16_t*)(ws + WS_WOUT) + (size_t)l * DM * DM, MP, DM, DM}; pg8::StaticOrder S; S.init(MP, DM, G, bx);
            pg8::EpiF32 E{(float*)(ws + WS_Y), DM};
#ifndef NO_G2
            pg8::gemm_phase<pg8::EpiF32, pg8::StaticOrder, true, true>(ldsa, g, S, E);
#endif
        }
        SEAM();
#ifndef NO_ROW
        if (IN_PH()) { PH_VARS(); row_phase<1>(nullptr, nullptr, nullptr, (float*)(ws + WS_X), (const float*)(ws + WS_Y), (bf16_t*)(ws + WS_H), LDF(T_POST_MIX_G) + (size_t)l * DM, LDF(T_PRE_FFN_G) + (size_t)l * DM, gw, ngw, lane); }
#endif
        SEAM();
        if (IN_PH()) {
            PH_VARS();
            pg8::Gemm g{(bf16_t*)(ws + WS_H), (bf16_t*)(ws + WS_WUP) + (size_t)l * DFF2 * DM, MP, DFF2, DM}; pg8::StaticOrder S; S.init(MP, DFF2, G, bx);
            pg8::EpiB16 E{(bf16_t*)(ws + WS_U), DFF2};
#ifndef NO_G3
            pg8::gemm_phase<pg8::EpiB16, pg8::StaticOrder, true, true>(ldsa, g, S, E);
#endif
        }
        SEAM();
#ifndef NO_CONV
        if (IN_PH()) { PH_VARS(); conv_phase((const bf16_t*)(ws + WS_U), (bf16_t*)(ws + WS_G), LDF(T_CONV_W) + (size_t)l * 3 * DFF2, LDF(T_CONV_B) + (size_t)l * DFF2, bx * NTHR + tid, G * NTHR); }
#endif
        SEAM();
        if (IN_PH()) {
            PH_VARS();
            pg8::Gemm g{(bf16_t*)(ws + WS_G), (bf16_t*)(ws + WS_WDN) + (size_t)l * DM * DFF, MP, DM, DFF}; pg8::StaticOrder S; S.init(MP, DM, G, bx);
            pg8::EpiF32 E{(float*)(ws + WS_Y), DM};
#ifndef NO_G4
            pg8::gemm_phase<pg8::EpiF32, pg8::StaticOrder, true, true>(ldsa, g, S, E);
#endif
        }
        SEAM();
#ifndef NO_ROW
        if (IN_PH()) {
            PH_VARS();
            if (l + 1 < DEPTH) row_phase<1>(nullptr, nullptr, nullptr, (float*)(ws + WS_X), (const float*)(ws + WS_Y), (bf16_t*)(ws + WS_H), LDF(T_POST_FFN_G) + (size_t)l * DM, LDF(T_PRE_MIX_G) + (size_t)(l + 1) * DM, gw, ngw, lane);
            else row_phase<2>(nullptr, nullptr, (float*)ldp_(lds, T_OUT), (float*)(ws + WS_X), (const float*)(ws + WS_Y), nullptr, LDF(T_POST_FFN_G) + (size_t)l * DM, nullptr, gw, ngw, lane);
        }
#endif
        if (l + 1 < DEPTH) SEAM(); else ++ph;
    }
#undef IN_PH
#undef SEAM
}
constexpr int N_PHASES = 1 + 8 * DEPTH;

#ifndef MULTI_LAUNCH
#define MULTI_LAUNCH 0
#endif
extern "C" void kernel_launch(void* const* d_in, const int* in_sizes, int n_in, void* d_out, int out_size, void* d_ws, size_t ws_size, hipStream_t stream) {
    static int grid = 0;
    if (grid == 0) {
        if (n_in != 17 || ws_size < WS_END) { fprintf(stderr, "kernel_launch: need 17 inputs and %zu bytes of workspace (got %d, %zu)\n", (size_t)WS_END, n_in, ws_size); grid = -1; return; }
        int dev = 0, cus = 0, per_cu = 0;
        hipGetDevice(&dev); hipDeviceGetAttribute(&cus, hipDeviceAttributeMultiprocessorCount, dev);
        if (hipFuncSetAttribute((const void*)hymba_fwd, hipFuncAttributeMaxDynamicSharedMemorySize, LDS_BYTES) != hipSuccess) { fprintf(stderr, "kernel_launch: hipFuncSetAttribute failed\n"); grid = -1; return; }
        if (hipOccupancyMaxActiveBlocksPerMultiprocessor(&per_cu, (const void*)hymba_fwd, NTHR, LDS_BYTES) != hipSuccess || per_cu < 1) { fprintf(stderr, "kernel_launch: occupancy query gave %d\n", per_cu); per_cu = 1; }
        (void)hipGetLastError();
        grid = cus * (per_cu > 1 ? 1 : per_cu);
        if (grid <= NGLA) { fprintf(stderr, "kernel_launch: grid %d too small\n", grid); grid = -1; return; }
    }
    if (grid < 0) return;
    Params p{};
    const float** pp = (const float**)&p;
    for (int i = 0; i < 17; ++i) pp[i] = (const float*)d_in[i];
    p.out = (float*)d_out; p.ws = (unsigned char*)d_ws;
#if MULTI_LAUNCH
    for (int ph = 0; ph < N_PHASES; ++ph) { p.ph_lo = ph; p.ph_hi = ph + 1; hipLaunchKernelGGL(hymba_fwd, dim3(grid), dim3(NTHR), LDS_BYTES, stream, p); }
#else
    p.ph_lo = 0; p.ph_hi = N_PHASES;
    void* args[] = {&p};
    hipError_t e = hipLaunchCooperativeKernel((const void*)hymba_fwd, dim3(grid), dim3(NTHR), args, LDS_BYTES, stream);
    if (e != hipSuccess) fprintf(stderr, "kernel_launch: cooperative launch failed: %s (grid %d)\n", hipGetErrorString(e), grid);
#endif
}
```

```cpp
#include <hip/hip_runtime.h>
#include <hip/hip_cooperative_groups.h>
#include <cstdio>
#include <cstdint>
namespace cg = cooperative_groups;
#define MULTI_LAUNCH 0

namespace pg8 {
#define PG8_LAS __attribute__((address_space(3)))
typedef unsigned short bf16_t;
typedef short bf16x8 __attribute__((ext_vector_type(8)));
typedef float f32x4 __attribute__((ext_vector_type(4)));
typedef unsigned u32x4 __attribute__((ext_vector_type(4)));
constexpr int BM = 256, BK = 64, HALF = 128, HTB = HALF * BK * 2  , STAGE_BYTES = 8 * HTB, NXCD = 8, WGM = 8;

__host__ __device__ __forceinline__ int lds_byte(int r, int c) { const int st = (r >> 4) * 2 + (c >> 5), rr = r & 15, cc = c & 31, ob = rr * 64 + cc * 2; return st * 1024 + (ob ^ (((ob >> 9) & 1) << 5)); }
__host__ __device__ __forceinline__ void stage_rc(int b, int& R, int& C) { const int st = b / 1024, sb = b % 1024, swz = sb ^ (((sb >> 9) & 1) << 5); R = (st >> 1) * 16 + swz / 64; C = (st & 1) * 32 + (swz % 64) / 2; }
__host__ __device__ __forceinline__ int perm32(int rho) { const int n = rho >> 4, i = rho & 15; return 8 * (i >> 2) + 4 * n + (i & 3); }

struct Unit { int pm, pn; };
struct Gemm { const bf16_t* A; const bf16_t* Bt; int M, N, K; };

struct StaticOrder {
    int nM, nN, nwg, G, c;
    __host__ __device__ void init(int M, int N, int G_, int c_) { nM = M / BM; nN = N / BM; nwg = nM * nN; G = G_; c = c_; }
    __host__ __device__ bool next(int i, Unit& u) const {
        const long L = (long)i * G + c; if (L >= nwg) return false;
        int wgid = (int)L; { const int q = nwg / NXCD, r = nwg % NXCD, xcd = wgid % NXCD, off = wgid / NXCD; wgid = (xcd < r ? xcd * (q + 1) : r * (q + 1) + (xcd - r) * q) + off; }
        const int nig = WGM * nN, gid = wgid / nig, fm = gid * WGM, gsz = (nM - fm) < WGM ? (nM - fm) : WGM;
        u.pm = fm + ((wgid % nig) % gsz); u.pn = (wgid % nig) / gsz; return true;
    }
    __device__ __forceinline__ void a_ready(const Unit&) const {}
    __device__ __forceinline__ void done(const Unit&) const {}
};
__device__ __forceinline__ unsigned cvt_pk_bf16(float lo, float hi) { unsigned r; asm volatile("v_cvt_pk_bf16_f32 %0, %1, %2" : "=v"(r) : "v"(lo), "v"(hi)); return r; }

struct EpiF32 {
    static constexpr bool PERM = false, AFTER_DRAIN = false;
    float* O; int ldc;
    __device__ __forceinline__ void operator()(const f32x4 (&acc)[2][2][4][2], const Unit& u, int wr, int wc, int fr, int fq) const {
        const int row0 = u.pm * BM + wr * 64 + fr, col0 = u.pn * BM + wc * 32 + 4 * fq;
#pragma unroll
        for (int ai = 0; ai < 2; ++ai)
#pragma unroll
            for (int m = 0; m < 4; ++m) { float* rowp = O + (size_t)(row0 + ai * HALF + m * 16) * ldc + col0;
#pragma unroll
                for (int bj = 0; bj < 2; ++bj)
#pragma unroll
                    for (int n = 0; n < 2; ++n) *(f32x4*)(rowp + bj * HALF + n * 16) = acc[ai][bj][m][n]; }
    }
};
struct EpiB16 {
    static constexpr bool PERM = true, AFTER_DRAIN = false;
    bf16_t* O; int ldc;
    __device__ __forceinline__ void operator()(const f32x4 (&acc)[2][2][4][2], const Unit& u, int wr, int wc, int fr, int fq) const {
        const int row0 = u.pm * BM + wr * 64 + fr, col0 = u.pn * BM + wc * 32 + 8 * fq;
#pragma unroll
        for (int ai = 0; ai < 2; ++ai)
#pragma unroll
            for (int m = 0; m < 4; ++m) { bf16_t* rowp = O + (size_t)(row0 + ai * HALF + m * 16) * ldc + col0;
#pragma unroll
                for (int bj = 0; bj < 2; ++bj) { const f32x4 v0 = acc[ai][bj][m][0], v1 = acc[ai][bj][m][1];
                    u32x4 w; w.x = cvt_pk_bf16(v0[0], v0[1]); w.y = cvt_pk_bf16(v0[2], v0[3]); w.z = cvt_pk_bf16(v1[0], v1[1]); w.w = cvt_pk_bf16(v1[2], v1[3]);
                    *(u32x4*)(rowp + bj * HALF) = w; } }
    }
};
struct EpiIn {
    static constexpr bool PERM = true, AFTER_DRAIN = false;
    bf16_t* P; int ldc; bf16_t* VtA; bf16_t* VtB; int LPtok; float qscale;
    __device__ __forceinline__ void operator()(const f32x4 (&acc)[2][2][4][2], const Unit& u, int wr, int wc, int fr, int fq) const {
        const int row0 = u.pm * BM + wr * 64 + fr, col0 = u.pn * BM + wc * 32 + 8 * fq;
        const bool isva = (u.pn >= 8 && u.pn < 12), isvb = (u.pn >= 16 && u.pn < 20);
        if (isva || isvb) {
            bf16_t* Vt = isva ? VtA : VtB; const int cbase = col0 - (isva ? 2048 : 4096);
#pragma unroll
            for (int ai = 0; ai < 2; ++ai)
#pragma unroll
                for (int m = 0; m < 4; ++m) { const int row = row0 + ai * HALF + m * 16; const int b = row / LPtok, t = row - b * LPtok;
#pragma unroll
                    for (int bj = 0; bj < 2; ++bj) { const f32x4 v0 = acc[ai][bj][m][0], v1 = acc[ai][bj][m][1];
                        const unsigned w0 = cvt_pk_bf16(v0[0], v0[1]), w1 = cvt_pk_bf16(v0[2], v0[3]), w2 = cvt_pk_bf16(v1[0], v1[1]), w3 = cvt_pk_bf16(v1[2], v1[3]);
                        bf16_t* dst = Vt + ((size_t)b * 1024 + cbase + bj * HALF) * LPtok + t;
                        dst[0] = (bf16_t)(w0 & 0xffffu); dst[(size_t)LPtok] = (bf16_t)(w0 >> 16); dst[(size_t)2 * LPtok] = (bf16_t)(w1 & 0xffffu); dst[(size_t)3 * LPtok] = (bf16_t)(w1 >> 16);
                        dst[(size_t)4 * LPtok] = (bf16_t)(w2 & 0xffffu); dst[(size_t)5 * LPtok] = (bf16_t)(w2 >> 16); dst[(size_t)6 * LPtok] = (bf16_t)(w3 & 0xffffu); dst[(size_t)7 * LPtok] = (bf16_t)(w3 >> 16); } }
        } else {
            const float sc = (u.pn < 4) ? qscale : 1.f;
#pragma unroll
            for (int ai = 0; ai < 2; ++ai)
#pragma unroll
                for (int m = 0; m < 4; ++m) { bf16_t* rowp = P + (size_t)(row0 + ai * HALF + m * 16) * ldc + col0;
#pragma unroll
                    for (int bj = 0; bj < 2; ++bj) { const f32x4 v0 = acc[ai][bj][m][0] * sc, v1 = acc[ai][bj][m][1] * sc;
                        u32x4 w; w.x = cvt_pk_bf16(v0[0], v0[1]); w.y = cvt_pk_bf16(v0[2], v0[3]); w.z = cvt_pk_bf16(v1[0], v1[1]); w.w = cvt_pk_bf16(v1[2], v1[3]);
                        *(u32x4*)(rowp + bj * HALF) = w; } }
        }
    }
};

template <class Epi, class Sched, bool ALIGN_EPI = false, bool SP2 = false>
__device__ __forceinline__ void gemm_phase(PG8_LAS unsigned char* lds, const Gemm g, const Sched& S, const Epi& E) {
    int tid_ = threadIdx.x; asm volatile("" : "+v"(tid_));
    const int tid = tid_, wid = __builtin_amdgcn_readfirstlane(tid >> 6), lane = tid & 63, wr = wid >> 2, wc = wid & 3, fr = lane & 15, fq = lane >> 4;
    const int K = g.K, nt = K / BK;
    unsigned voffA[2], voffB[2];
#pragma unroll
    for (int i = 0; i < 2; ++i) { int R, C; stage_rc(tid * 16 + i * 8192, R, C); const int Rb = Epi::PERM ? ((R & ~31) + perm32(R & 31)) : R;
        voffA[i] = (unsigned)(R * K + C) * 2u; voffB[i] = (unsigned)(Rb * K + C) * 2u; }
    const size_t kstep = (size_t)(BK * 2);
    const size_t hstep = (size_t)HALF * K * 2;
    const size_t tstep = 2 * hstep;
    const unsigned ldsw = (unsigned)wid * 1024u;
    const int aoff = lds_byte(wr * 64 + fr, fq * 8), boff = lds_byte(wc * 32 + fr, fq * 8);
#define PG8_SA(b, h) (((b) * 2 + (h)) * HTB)
#define PG8_SB(b, h) ((4 + (b) * 2 + (h)) * HTB)
#define PG8_STAGE(bufoff, gbase, voff) do { _Pragma("unroll") for (int _i = 0; _i < 2; ++_i) \
        __builtin_amdgcn_global_load_lds((const unsigned*)((const char*)(gbase) + (voff)[_i]), (PG8_LAS unsigned*)(lds + (bufoff) + ldsw + _i * 8192), 16, 0, 0); } while (0)
#define PG8_LDA(dst, b, h) do { _Pragma("unroll") for (int m = 0; m < 4; ++m) _Pragma("unroll") for (int k = 0; k < 2; ++k) dst[m][k] = *(const PG8_LAS bf16x8*)(lds + PG8_SA(b, h) + aoff + m * 2048 + k * 1024); } while (0)
#define PG8_LDB(dst, b, h) do { _Pragma("unroll") for (int n = 0; n < 2; ++n) _Pragma("unroll") for (int k = 0; k < 2; ++k) dst[n][k] = *(const PG8_LAS bf16x8*)(lds + PG8_SB(b, h) + boff + n * 2048 + k * 1024); } while (0)
#define PG8_MMA(ai, bj, At, Bt) do { __builtin_amdgcn_s_setprio(1); _Pragma("unroll") for (int m = 0; m < 4; ++m) _Pragma("unroll") for (int n = 0; n < 2; ++n) _Pragma("unroll") for (int k = 0; k < 2; ++k) \
        acc[ai][bj][m][n] = __builtin_amdgcn_mfma_f32_16x16x32_bf16(Bt[n][k], At[m][k], acc[ai][bj][m][n], 0, 0, 0); __builtin_amdgcn_s_setprio(0); } while (0)
#define PG8_WAIT_V(n) asm volatile("s_waitcnt vmcnt(" #n ")" ::: "memory")
#define PG8_WAIT_L(n) asm volatile("s_waitcnt lgkmcnt(" #n ")" ::: "memory")
#define PG8_BAR __builtin_amdgcn_s_barrier()
#define PG8_SCHED __builtin_amdgcn_sched_barrier(0)
    Unit cur, nxt; int ui = 0;
    if (!S.next(0, cur)) return;
    f32x4 acc[2][2][4][2];
#pragma unroll
    for (int a = 0; a < 2; ++a)
#pragma unroll
        for (int b = 0; b < 2; ++b)
#pragma unroll
            for (int m = 0; m < 4; ++m)
#pragma unroll
                for (int n = 0; n < 2; ++n) acc[a][b][m][n] = (f32x4){0.f, 0.f, 0.f, 0.f};
    bf16x8 At[4][2], B0[2][2], B1[2][2];
    const char* cA = (const char*)g.A + (size_t)cur.pm * tstep; const char* cB = (const char*)g.Bt + (size_t)cur.pn * tstep;
    S.a_ready(cur);
    if constexpr (SP2) {
        PG8_STAGE(PG8_SB(0, 0), cB, voffB); PG8_STAGE(PG8_SB(0, 1), cB + hstep, voffB); PG8_STAGE(PG8_SA(0, 0), cA, voffA); PG8_STAGE(PG8_SA(0, 1), cA + hstep, voffA);
        if (wr == 1) PG8_BAR;
        PG8_WAIT_V(2); PG8_BAR;
        PG8_STAGE(PG8_SB(1, 0), cB + kstep, voffB); PG8_STAGE(PG8_SA(1, 0), cA + kstep, voffA); PG8_STAGE(PG8_SB(1, 1), cB + hstep + kstep, voffB);
        PG8_WAIT_V(6); PG8_BAR;
    } else {
        PG8_STAGE(PG8_SB(0, 0), cB, voffB); PG8_STAGE(PG8_SA(0, 0), cA, voffA); PG8_STAGE(PG8_SB(0, 1), cB + hstep, voffB); PG8_STAGE(PG8_SA(0, 1), cA + hstep, voffA);
        if (wr == 1) PG8_BAR;
        PG8_WAIT_V(4); PG8_BAR;
        PG8_STAGE(PG8_SB(1, 0), cB + kstep, voffB); PG8_STAGE(PG8_SA(1, 0), cA + kstep, voffA); PG8_STAGE(PG8_SB(1, 1), cB + hstep + kstep, voffB);
        PG8_WAIT_V(6); PG8_BAR;
    }
    for (;;) {
        const bool has_next = S.next(ui + 1, nxt);
        const char* nA = has_next ? (const char*)g.A + (size_t)nxt.pm * tstep : cA; const char* nB = has_next ? (const char*)g.Bt + (size_t)nxt.pn * tstep : cB;
        for (int t = 0; t < nt; t += 2) {
            const bool last = (t == nt - 2);
            const char* a1 = cA + (size_t)(t + 1) * kstep;
            const char* a2 = last ? nA : cA + (size_t)(t + 2) * kstep; const char* b2 = last ? nB : cB + (size_t)(t + 2) * kstep;
            const char* a3 = a2 + kstep; const char* b3 = b2 + kstep;
            if (last && has_next) S.a_ready(nxt);
            if constexpr (SP2) {
            PG8_LDB(B0, 0, 0); PG8_LDB(B1, 0, 1); PG8_SCHED; PG8_LDA(At, 0, 0); PG8_STAGE(PG8_SA(1, 1), a1 + hstep, voffA);
            PG8_WAIT_V(8); PG8_WAIT_L(0); PG8_BAR; PG8_MMA(0, 0, At, B0); PG8_MMA(0, 1, At, B1); PG8_BAR; PG8_SCHED;
            PG8_LDA(At, 0, 1); PG8_STAGE(PG8_SB(0, 0), b2, voffB); PG8_STAGE(PG8_SB(0, 1), b2 + hstep, voffB); PG8_STAGE(PG8_SA(0, 0), a2, voffA);
            PG8_WAIT_V(8); PG8_WAIT_L(0); PG8_BAR; PG8_MMA(1, 0, At, B0); PG8_MMA(1, 1, At, B1); PG8_BAR; PG8_SCHED;
            PG8_LDB(B0, 1, 0); PG8_LDB(B1, 1, 1); PG8_SCHED; PG8_LDA(At, 1, 0); PG8_STAGE(PG8_SA(0, 1), a2 + hstep, voffA);
            PG8_WAIT_V(8); PG8_WAIT_L(0); PG8_BAR; PG8_MMA(0, 0, At, B0); PG8_MMA(0, 1, At, B1); PG8_BAR; PG8_SCHED;
            PG8_LDA(At, 1, 1); PG8_STAGE(PG8_SB(1, 0), b3, voffB); PG8_STAGE(PG8_SB(1, 1), b3 + hstep, voffB); PG8_STAGE(PG8_SA(1, 0), a3, voffA);
            PG8_WAIT_V(8); PG8_WAIT_L(0); PG8_BAR; PG8_MMA(1, 0, At, B0); PG8_MMA(1, 1, At, B1); PG8_BAR; PG8_SCHED;
            } else {
            PG8_LDB(B0, 0, 0); PG8_SCHED; PG8_LDA(At, 0, 0); PG8_STAGE(PG8_SA(1, 1), a1 + hstep, voffA);
            PG8_WAIT_L(8); PG8_BAR; PG8_WAIT_L(0); PG8_MMA(0, 0, At, B0); PG8_BAR; PG8_SCHED;
            PG8_LDB(B1, 0, 1); PG8_STAGE(PG8_SB(0, 0), b2, voffB);
            PG8_BAR; PG8_WAIT_L(0); PG8_MMA(0, 1, At, B1); PG8_BAR;
            PG8_LDA(At, 0, 1); PG8_STAGE(PG8_SA(0, 0), a2, voffA);
            PG8_BAR; PG8_WAIT_L(0); PG8_MMA(1, 0, At, B0); PG8_BAR; PG8_SCHED;
            PG8_STAGE(PG8_SB(0, 1), b2 + hstep, voffB);
            PG8_WAIT_V(6); PG8_BAR; PG8_MMA(1, 1, At, B1); PG8_BAR;
            PG8_LDB(B0, 1, 0); PG8_SCHED; PG8_LDA(At, 1, 0); PG8_STAGE(PG8_SA(0, 1), a2 + hstep, voffA);
            PG8_WAIT_L(8); PG8_BAR; PG8_WAIT_L(0); PG8_MMA(0, 0, At, B0); PG8_BAR; PG8_SCHED;
            PG8_LDB(B1, 1, 1); PG8_STAGE(PG8_SB(1, 0), b3, voffB);
            PG8_BAR; PG8_WAIT_L(0); PG8_MMA(0, 1, At, B1); PG8_BAR;
            PG8_LDA(At, 1, 1); PG8_STAGE(PG8_SA(1, 0), a3, voffA);
            PG8_BAR; PG8_WAIT_L(0); PG8_MMA(1, 0, At, B0); PG8_BAR; PG8_SCHED;
            PG8_STAGE(PG8_SB(1, 1), b3 + hstep, voffB);
            PG8_WAIT_V(6); PG8_BAR; PG8_MMA(1, 1, At, B1); PG8_BAR;
            }
        }
        if constexpr (ALIGN_EPI) { if (wr == 0) PG8_BAR; }
        if constexpr (!Epi::AFTER_DRAIN) { E(acc, cur, wr, wc, fr, fq); S.done(cur); }
        if (!has_next) break;
#pragma unroll
        for (int a = 0; a < 2; ++a)
#pragma unroll
            for (int b = 0; b < 2; ++b)
#pragma unroll
                for (int m = 0; m < 4; ++m)
#pragma unroll
                    for (int n = 0; n < 2; ++n) acc[a][b][m][n] = (f32x4){0.f, 0.f, 0.f, 0.f};
        cur = nxt; cA = nA; cB = nB; ++ui;
        if constexpr (ALIGN_EPI) { if (wr == 1) PG8_BAR; }
    }
    PG8_WAIT_V(0);
    if constexpr (!ALIGN_EPI) { if (wr == 0) PG8_BAR; }
    PG8_BAR;
    if constexpr (Epi::AFTER_DRAIN) { E.fused(acc, cur, wr, wc, fr, fq, lds, wid, lane); S.done(cur); }
#undef PG8_SA
#undef PG8_SB
#undef PG8_STAGE
#undef PG8_LDA
#undef PG8_LDB
#undef PG8_MMA
#undef PG8_WAIT_V
#undef PG8_WAIT_L
#undef PG8_BAR
#undef PG8_SCHED
}
}

#define LAS __attribute__((address_space(3)))
typedef unsigned short bf16_t;
typedef short bf16x8 __attribute__((ext_vector_type(8)));
typedef float f32x4 __attribute__((ext_vector_type(4)));
typedef float f32x16 __attribute__((ext_vector_type(16)));
typedef unsigned u32x4 __attribute__((ext_vector_type(4)));
typedef unsigned u32x2 __attribute__((ext_vector_type(2)));
typedef float f32x2_t __attribute__((ext_vector_type(2)));
typedef __bf16 bf16x2_t __attribute__((ext_vector_type(2)));

constexpr int DM = 2048, NB = 4, SEQ = 2048, DEPTH = 4, NMETA = 16;
constexpr int LT = SEQ + NMETA;
constexpr int LP = 2112;
constexpr int MP = NB * LP;
constexpr int INC = 6160, INP = 6400;
constexpr int DFF = 5632, DFF2 = 11264;
constexpr float EPS = 1e-6f;
constexpr int NTHR = 512, NWAVE = 8;
constexpr int LDS_BYTES = 135168;

constexpr size_t al256(size_t x) { return (x + 255) & ~(size_t)255; }
constexpr size_t SZ_WIN = (size_t)INP * DM * 2, SZ_WOUT = (size_t)DM * DM * 2, SZ_WUP = (size_t)DFF2 * DM * 2, SZ_WDN = (size_t)DM * DFF * 2;
constexpr size_t WS_WIN = 0;
constexpr size_t WS_WOUT = WS_WIN + DEPTH * SZ_WIN;
constexpr size_t WS_WUP = WS_WOUT + DEPTH * SZ_WOUT;
constexpr size_t WS_WDN = WS_WUP + DEPTH * SZ_WUP;
constexpr size_t WS_X = WS_WDN + DEPTH * SZ_WDN;
constexpr size_t WS_H = WS_X + (size_t)MP * DM * 4;
constexpr size_t WS_P = WS_H + (size_t)MP * DM * 2;
constexpr size_t WS_VTA = WS_P + (size_t)MP * INP * 2;
constexpr size_t WS_VTB = WS_VTA + al256((size_t)NB * 1024 * LP * 2 + 4096);
constexpr size_t WS_OC = WS_VTB + al256((size_t)NB * 1024 * LP * 2 + 4096);
constexpr size_t WS_Y = WS_OC + (size_t)MP * DM * 2;
constexpr size_t WS_U = WS_Y + (size_t)MP * DM * 4;
constexpr size_t WS_G = WS_U + (size_t)MP * DFF2 * 2;
constexpr size_t WS_KV = WS_G + (size_t)MP * DFF * 2;
constexpr size_t WS_SP = WS_KV + (size_t)528 * 32768 * 4;
constexpr size_t WS_DEC = WS_SP + (size_t)528 * 65536;
constexpr size_t WS_END = WS_DEC + (size_t)528 * 128 * 4;

struct Params {
    const float *x, *meta, *pre_mix_g, *w_in, *da_lambda, *da_subln_g, *gate_w2, *gate_b, *gla_norm_g, *w_out, *post_mix_g, *pre_ffn_g, *w_up, *conv_w, *conv_b, *w_down, *post_ffn_g;
    float* out; unsigned char* ws; int ph_lo, ph_hi;
};

__device__ __forceinline__ unsigned pack2(float lo, float hi) { f32x2_t v = {lo, hi}; bf16x2_t b = __builtin_convertvector(v, bf16x2_t); return __builtin_bit_cast(unsigned, b); }
__device__ __forceinline__ float bf2f(unsigned short u) { return __uint_as_float(((unsigned)u) << 16); }
__device__ __forceinline__ float bflo(unsigned u) { return __uint_as_float(u << 16); }
__device__ __forceinline__ float bfhi(unsigned u) { return __uint_as_float(u & 0xffff0000u); }
__device__ __forceinline__ float wave_sum(float v) {
#pragma unroll
    for (int o = 1; o < 64; o <<= 1) v += __shfl_xor(v, o);
    return v;
}
#define MFMA32(a, b, c) __builtin_amdgcn_mfma_f32_32x32x16_bf16((a), (b), (c), 0, 0, 0)
__device__ __forceinline__ bf16x8 pack8(const f32x16& x, int s) {
    u32x4 p; p.x = pack2(x[8 * s + 0], x[8 * s + 1]); p.y = pack2(x[8 * s + 2], x[8 * s + 3]); p.z = pack2(x[8 * s + 4], x[8 * s + 5]); p.w = pack2(x[8 * s + 6], x[8 * s + 7]);
    return __builtin_bit_cast(bf16x8, p);
}
__device__ __forceinline__ int swap23(int i) { return (i & ~12) | ((i & 4) << 1) | ((i & 8) >> 1); }
__device__ __forceinline__ int crow(int r, int hi) { return (r & 3) + 8 * (r >> 2) + 4 * hi; }

__device__ __forceinline__ void transpose_item(const float* W, int K, int Nsrc, bf16_t* WT, LAS float* scr, int item, int nblk, int lane) {
    const int kb = item / nblk, nb = item - kb * nblk, k0 = 64 * kb, n0 = 32 * nb;
    const int n = n0 + (lane & 31); const bool ok = n < Nsrc;
#pragma unroll 8
    for (int i = 0; i < 32; ++i) { const int kk = 2 * i + (lane >> 5); scr[kk * 33 + (lane & 31)] = ok ? W[(size_t)(k0 + kk) * Nsrc + n] : 0.f; }
    asm volatile("s_waitcnt lgkmcnt(0)" ::: "memory");
    const int c = lane & 7;
#pragma unroll
    for (int j = 0; j < 4; ++j) { const int nn = (lane >> 3) + 8 * j; const LAS float* s = scr + (8 * c) * 33 + nn;
        u32x4 o; o.x = pack2(s[0 * 33], s[1 * 33]); o.y = pack2(s[2 * 33], s[3 * 33]); o.z = pack2(s[4 * 33], s[5 * 33]); o.w = pack2(s[6 * 33], s[7 * 33]);
        *(u32x4*)(WT + (size_t)(n0 + nn) * K + k0 + 8 * c) = o; }
    asm volatile("s_waitcnt lgkmcnt(0)" ::: "memory");
}

template <int MODE>
__device__ __forceinline__ void row_phase(const float* xin, const float* meta, float* outp, float* X, const float* Y, bf16_t* H, const float* g1, const float* g2, int gw, int ngw, int lane) {
    for (int row = gw; row < MP; row += ngw) {
        const int b = row / LP, t = row - b * LP;
        f32x4 xv[8];
        float* xr = X + (size_t)row * DM;
        if (MODE == 0) {
            const float* src = (t < NMETA) ? meta + (size_t)t * DM : xin + ((size_t)b * SEQ + (t - NMETA)) * DM;
#pragma unroll
            for (int j = 0; j < 8; ++j) xv[j] = (t < LT) ? *(const f32x4*)(src + 4 * (lane + 64 * j)) : (f32x4){0.f, 0.f, 0.f, 0.f};
        } else {
            const float* yr = Y + (size_t)row * DM;
            f32x4 yv[8]; float ss = 0.f;
#pragma unroll
            for (int j = 0; j < 8; ++j) { yv[j] = *(const f32x4*)(yr + 4 * (lane + 64 * j)); ss += (yv[j].x * yv[j].x + yv[j].y * yv[j].y) + (yv[j].z * yv[j].z + yv[j].w * yv[j].w); }
            const float r1 = rsqrtf(wave_sum(ss) * (1.f / DM) + EPS);
#pragma unroll
            for (int j = 0; j < 8; ++j) { const f32x4 g = *(const f32x4*)(g1 + 4 * (lane + 64 * j)); const f32x4 xo = *(const f32x4*)(xr + 4 * (lane + 64 * j)); xv[j] = xo + yv[j] * r1 * g; }
        }
        if (MODE == 2) {
            if (t >= NMETA && t < LT) { float* orow = outp + ((size_t)b * SEQ + (t - NMETA)) * DM;
#pragma unroll
                for (int j = 0; j < 8; ++j) *(f32x4*)(orow + 4 * (lane + 64 * j)) = xv[j]; }
        } else {
            float ss = 0.f;
#pragma unroll
            for (int j = 0; j < 8; ++j) { *(f32x4*)(xr + 4 * (lane + 64 * j)) = xv[j]; ss += (xv[j].x * xv[j].x + xv[j].y * xv[j].y) + (xv[j].z * xv[j].z + xv[j].w * xv[j].w); }
            const float r2 = rsqrtf(wave_sum(ss) * (1.f / DM) + EPS);
            bf16_t* hr = H + (size_t)row * DM;
#pragma unroll
            for (int j = 0; j < 8; ++j) { const f32x4 g = *(const f32x4*)(g2 + 4 * (lane + 64 * j)); const f32x4 v = xv[j] * r2 * g;
                u32x2 w; w.x = pack2(v.x, v.y); w.y = pack2(v.z, v.w); *(u32x2*)(hr + 4 * (lane + 64 * j)) = w; }
        }
    }
}

__device__ __forceinline__ void conv_phase(const bf16_t* U, bf16_t* G, const float* cw, const float* cb, int gtid, int ngt) {
    constexpr int NCG = DFF / 8, NSTRIP = MP / 16;
    for (int it = gtid; it < NCG * NSTRIP; it += ngt) {
        const int s = it / NCG, cgp = it - s * NCG, j0 = 8 * cgp, row0 = 16 * s; const int t0 = row0 % LP;
        float wa[3][8], wv[3][8], ba[8], bv[8];
#pragma unroll
        for (int i = 0; i < 3; ++i)
#pragma unroll
            for (int e = 0; e < 8; e += 4) { const f32x4 a = *(const f32x4*)(cw + (size_t)i * DFF2 + j0 + e), v = *(const f32x4*)(cw + (size_t)i * DFF2 + DFF + j0 + e);
                wa[i][e] = a.x; wa[i][e + 1] = a.y; wa[i][e + 2] = a.z; wa[i][e + 3] = a.w; wv[i][e] = v.x; wv[i][e + 1] = v.y; wv[i][e + 2] = v.z; wv[i][e + 3] = v.w; }
#pragma unroll
        for (int e = 0; e < 8; e += 4) { const f32x4 a = *(const f32x4*)(cb + j0 + e), v = *(const f32x4*)(cb + DFF + j0 + e);
            ba[e] = a.x; ba[e + 1] = a.y; ba[e + 2] = a.z; ba[e + 3] = a.w; bv[e] = v.x; bv[e + 1] = v.y; bv[e + 2] = v.z; bv[e + 3] = v.w; }
        u32x4 a2 = {0, 0, 0, 0}, a1 = {0, 0, 0, 0}, v2 = {0, 0, 0, 0}, v1 = {0, 0, 0, 0};
        if (t0 > 0) { const bf16_t* u = U + (size_t)(row0 - 2) * DFF2 + j0; a2 = *(const u32x4*)u; v2 = *(const u32x4*)(u + DFF); a1 = *(const u32x4*)(u + DFF2); v1 = *(const u32x4*)(u + DFF2 + DFF); }
#pragma unroll 4
        for (int r = 0; r < 16; ++r) {
            const bf16_t* u = U + (size_t)(row0 + r) * DFF2 + j0;
            const u32x4 a0 = *(const u32x4*)u, v0 = *(const u32x4*)(u + DFF);
            unsigned ow[4];
#pragma unroll
            for (int q = 0; q < 4; ++q) {
                const float al = ba[2 * q] + wa[0][2 * q] * bflo(a2[q]) + wa[1][2 * q] * bflo(a1[q]) + wa[2][2 * q] * bflo(a0[q]);
                const float ah = ba[2 * q + 1] + wa[0][2 * q + 1] * bfhi(a2[q]) + wa[1][2 * q + 1] * bfhi(a1[q]) + wa[2][2 * q + 1] * bfhi(a0[q]);
                const float vl = bv[2 * q] + wv[0][2 * q] * bflo(v2[q]) + wv[1][2 * q] * bflo(v1[q]) + wv[2][2 * q] * bflo(v0[q]);
                const float vh = bv[2 * q + 1] + wv[0][2 * q + 1] * bfhi(v2[q]) + wv[1][2 * q + 1] * bfhi(v1[q]) + wv[2][2 * q + 1] * bfhi(v0[q]);
                const float gl = al / (1.f + __expf(-al)) * vl, gh = ah / (1.f + __expf(-ah)) * vh;
                ow[q] = pack2(gl, gh);
            }
            *(u32x4*)(G + (size_t)(row0 + r) * DFF + j0) = (u32x4){ow[0], ow[1], ow[2], ow[3]};
            a2 = a1; a1 = a0; v2 = v1; v1 = v0;
        }
    }
}

constexpr int AT_KSTR = 144, AT_K1 = 64 * AT_KSTR  , AT_VOFF = 2 * AT_K1  , AT_BUF = AT_VOFF + 128 * AT_KSTR  ;
__device__ __forceinline__ void attn_unit(unsigned char* lds, const bf16_t* __restrict__ P, const bf16_t* __restrict__ Vt, bf16_t* __restrict__ OC, const float* subg_lds,
                                          int b, int h, int qt, float lam, float omli) {
    int tid_ = threadIdx.x; asm volatile("" : "+v"(tid_));
    const int tid = tid_, lane = tid & 63, w = __builtin_amdgcn_readfirstlane(tid >> 6), l31 = lane & 31, hi = lane >> 5;
    const int c = w >> 2, qb = w & 3;
    const int nkt = (2 * qt + 2 < 33) ? 2 * qt + 2 : 33;
    const int qrow0 = 128 * qt + 32 * qb;
    const bool active = qrow0 < LP;
    bf16x8 qf[4];
    {
        const bf16_t* qp = P + (size_t)(b * LP + (active ? qrow0 : 0) + l31) * INP + h * 128 + c * 64 + hi * 8;
#pragma unroll
        for (int ks = 0; ks < 4; ++ks) qf[ks] = *(const bf16x8*)(qp + 16 * ks);
    }
    f32x16 O[4];
#pragma unroll
    for (int v = 0; v < 4; ++v)
#pragma unroll
        for (int r = 0; r < 16; ++r) O[v][r] = 0.f;
    float m = -INFINITY, l = 0.f;
    const bf16_t* kbase = P + (size_t)(b * LP) * INP + 1024 + h * 128;
    const bf16_t* vbase = Vt + (size_t)(b * 1024 + h * 128) * LP;
    const int kkey0 = tid >> 4, kch = tid & 15;
    const int vdv0 = tid >> 3, vch = tid & 7;
    const bf16_t* ksrc = kbase + (size_t)kkey0 * INP + kch * 8;
    const bf16_t* vsrc = vbase + (size_t)vdv0 * LP + vch * 8;
    const int kdst = (kch >> 3) * AT_K1 + kkey0 * AT_KSTR + (kch & 7) * 16;
    const int vdst = AT_VOFF + vdv0 * AT_KSTR + vch * 16;
    u32x4 tk0, tk1, tv0, tv1;
#define AT_LOAD(kt) do { const bf16_t* ks_ = ksrc + (size_t)(64 * (kt)) * INP; tk0 = *(const u32x4*)ks_; tk1 = *(const u32x4*)(ks_ + (size_t)32 * INP); \
        const bf16_t* vs_ = vsrc + 64 * (kt); tv0 = *(const u32x4*)vs_; tv1 = *(const u32x4*)(vs_ + (size_t)64 * LP); } while (0)
#define AT_STORE(buf) do { unsigned char* d_ = lds + (buf) * AT_BUF; *(u32x4*)(d_ + kdst) = tk0; *(u32x4*)(d_ + kdst + 32 * AT_KSTR) = tk1; \
        *(u32x4*)(d_ + vdst) = tv0; *(u32x4*)(d_ + vdst + 64 * AT_KSTR) = tv1; } while (0)
    AT_LOAD(0); AT_STORE(0);
    __syncthreads();
    const int krow_off = c * AT_K1 + swap23(l31) * AT_KSTR + hi * 16;
    const int vrow_off = AT_VOFF + l31 * AT_KSTR + hi * 16;
    for (int kt = 0; kt < nkt; ++kt) {
        const bool more = kt + 1 < nkt;
        if (more) AT_LOAD(kt + 1);
        const unsigned char* buf = lds + (kt & 1) * AT_BUF;
        if (active && 64 * kt <= qrow0 + 31) {
            f32x16 s0, s1;
#pragma unroll
            for (int r = 0; r < 16; ++r) { s0[r] = 0.f; s1[r] = 0.f; }
#pragma unroll
            for (int ks = 0; ks < 4; ++ks) {
                const bf16x8 k0 = *(const bf16x8*)(buf + krow_off + ks * 32), k1 = *(const bf16x8*)(buf + krow_off + 32 * AT_KSTR + ks * 32);
                s0 = MFMA32(k0, qf[ks], s0); s1 = MFMA32(k1, qf[ks], s1);
            }
            if (64 * kt + 63 > qrow0) {
                const int q = qrow0 + l31, kb0 = 64 * kt + 8 * hi;
#pragma unroll
                for (int r = 0; r < 16; ++r) { const int key = kb0 + 16 * (r >> 3) + (r & 7); if (key > q) s0[r] = -INFINITY; if (key + 32 > q) s1[r] = -INFINITY; }
            }
            float mx = fmaxf(s0[0], s1[0]);
#pragma unroll
            for (int r = 1; r < 16; ++r) mx = fmaxf(mx, fmaxf(s0[r], s1[r]));
            mx = fmaxf(mx, __shfl_xor(mx, 32));
            const float mn = fmaxf(m, mx), alpha = __builtin_amdgcn_exp2f(m - mn);
            m = mn;
            float sum = 0.f;
#pragma unroll
            for (int r = 0; r < 16; ++r) { s0[r] = __builtin_amdgcn_exp2f(s0[r] - mn); s1[r] = __builtin_amdgcn_exp2f(s1[r] - mn); sum += s0[r] + s1[r]; }
            l = l * alpha + sum;
#pragma unroll
            for (int v = 0; v < 4; ++v)
#pragma unroll
                for (int r = 0; r < 16; ++r) O[v][r] *= alpha;
            const bf16x8 p00 = pack8(s0, 0), p01 = pack8(s0, 1), p10 = pack8(s1, 0), p11 = pack8(s1, 1);
#pragma unroll
            for (int v = 0; v < 4; ++v) {
                const unsigned char* vp = buf + vrow_off + v * 32 * AT_KSTR;
                const bf16x8 a0 = *(const bf16x8*)(vp), a1 = *(const bf16x8*)(vp + 32), a2 = *(const bf16x8*)(vp + 64), a3 = *(const bf16x8*)(vp + 96);
                O[v] = MFMA32(a0, p00, O[v]); O[v] = MFMA32(a1, p01, O[v]); O[v] = MFMA32(a2, p10, O[v]); O[v] = MFMA32(a3, p11, O[v]);
            }
        }
        if (more) AT_STORE((kt + 1) & 1);
        __syncthreads();
    }
#undef AT_LOAD
#undef AT_STORE
    l += __shfl_xor(l, 32);
    const float inv = 1.f / l;
    float* ex = (float*)lds + (size_t)qb * 4096;
    if (c == 1 && active) {
#pragma unroll
        for (int v = 0; v < 4; ++v)
#pragma unroll
            for (int r = 0; r < 16; ++r) ex[(v * 16 + r) * 64 + lane] = O[v][r] * inv;
    }
    __syncthreads();
    if (c == 0 && active) {
        float ss = 0.f;
#pragma unroll
        for (int v = 0; v < 4; ++v)
#pragma unroll
            for (int r = 0; r < 16; ++r) { const float o = O[v][r] * inv - lam * ex[(v * 16 + r) * 64 + lane]; O[v][r] = o; ss += o * o; }
        ss += __shfl_xor(ss, 32);
        const float rs = rsqrtf(ss * (1.f / 128.f) + EPS) * omli;
        bf16_t* orow = OC + (size_t)(b * LP + qrow0 + l31) * DM + h * 128;
#pragma unroll
        for (int v = 0; v < 4; ++v)
#pragma unroll
            for (int r4 = 0; r4 < 4; ++r4) { const int dv = 32 * v + 8 * r4 + 4 * hi; const f32x4 g = *(const f32x4*)(subg_lds + dv);
                u32x2 wv; wv.x = pack2(O[v][4 * r4] * rs * g.x, O[v][4 * r4 + 1] * rs * g.y); wv.y = pack2(O[v][4 * r4 + 2] * rs * g.z, O[v][4 * r4 + 3] * rs * g.w);
                *(u32x2*)(orow + dv) = wv; }
    }
    __syncthreads();
}

constexpr int GL_QSTR = 272, GL_TSTR = 144;
constexpr int GL_QIN = 0, GL_KIN = 64 * GL_QSTR  , GL_KOUT = 2 * 64 * GL_QSTR  , GL_VT = GL_KOUT + 128 * GL_TSTR  , GL_LR = GL_VT + 256 * GL_TSTR  ,
              GL_SEG = GL_LR + 4096, GL_DEC = GL_SEG + 2048, GL_NG = GL_DEC + 512, GL_RAWQ = GL_NG + 1024  , GL_RAWK = GL_RAWQ + 16384, GL_END = GL_RAWK + 16384  ;
constexpr int GL_OSTR = 260;
constexpr int NCHUNK = LP / 64, NGU = 16 * NCHUNK;

#define GL_GATE() \
        float bc[16]; float run = 0.f; \
        _Pragma("unroll") for (int i = 0; i < 16; ++i) { \
            const float* lr = LR + (16 * seg + i) * 16; float z = b2r; \
            _Pragma("unroll") for (int j = 0; j < 16; j += 4) { const f32x4 v = *(const f32x4*)(lr + j); z += v.x * w2r[j] + v.y * w2r[j + 1] + v.z * w2r[j + 2] + v.w * w2r[j + 3]; } \
            const float ls = fminf(z, 0.f) - __logf(1.f + __expf(-fabsf(z))); \
            run += ls * (1.f / 16.f); bc[i] = run; } \
        SEG[seg * 128 + d] = run; \
        __syncthreads(); \
        float off = 0.f, tot = 0.f; \
        _Pragma("unroll") for (int s = 0; s < 4; ++s) { const float v = SEG[s * 128 + d]; tot += v; if (s < seg) off += v; }

__device__ __forceinline__ void gla_m1(unsigned char* lds, const bf16_t* __restrict__ P, const bf16_t* __restrict__ Vt, float* __restrict__ KV, float* __restrict__ DECb,
                                       const float* __restrict__ w2, const float* __restrict__ b2, int u) {
    int tid_ = threadIdx.x; asm volatile("" : "+v"(tid_));
    const int tid = tid_, lane = tid & 63, w = __builtin_amdgcn_readfirstlane(tid >> 6), l31 = lane & 31, hi = lane >> 5;
    const int bh = u / NCHUNK, n = u - bh * NCHUNK, b = bh >> 2, h = bh & 3;
    const int d = tid & 127, seg = tid >> 7;
    float w2r[16];
#pragma unroll
    for (int j = 0; j < 16; ++j) w2r[j] = w2[(size_t)j * 512 + h * 128 + d];
    const float b2r = b2[h * 128 + d];
    float* LR = (float*)(lds + GL_LR); float* SEG = (float*)(lds + GL_SEG);
    const int tok8 = tid >> 3, part = tid & 7;
    const size_t R0 = (size_t)b * LP + 64 * n;
    const unsigned lrw = *(const unsigned*)(P + (R0 + tok8) * INP + 6144 + 2 * part);
    { const bf16_t* kp = P + (R0 + (tid >> 4)) * INP + 3584 + h * 128 + (tid & 15) * 8;
      const u32x4 k0 = *(const u32x4*)kp, k1 = *(const u32x4*)(kp + (size_t)32 * INP);
      unsigned char* rk = lds + GL_RAWK + (tid >> 4) * 256 + (tid & 15) * 16;
      *(u32x4*)rk = k0; *(u32x4*)(rk + 32 * 256) = k1; }
    u32x4 vt[4];
    { const bf16_t* vp = Vt + ((size_t)b * 1024 + h * 256 + (tid >> 3)) * LP + 64 * n + (tid & 7) * 8;
#pragma unroll
      for (int i = 0; i < 4; ++i) vt[i] = *(const u32x4*)(vp + (size_t)(64 * i) * LP); }
    LR[tok8 * 16 + 2 * part] = bflo(lrw); LR[tok8 * 16 + 2 * part + 1] = bfhi(lrw);
    __syncthreads();
    GL_GATE()
    if (seg == 0) DECb[(size_t)u * 128 + d] = __expf(tot);
    {
        unsigned ko[8];
#pragma unroll
        for (int i = 0; i < 16; i += 2) {
            const float b0 = bc[i] + off, b1 = bc[i + 1] + off;
            const bf16_t* rk = (const bf16_t*)(lds + GL_RAWK + (16 * seg + i) * 256) + d;
            ko[i >> 1] = pack2(bf2f(rk[0]) * __expf(tot - b0), bf2f(rk[128]) * __expf(tot - b1));
        }
        unsigned char* kod = lds + GL_KOUT + d * GL_TSTR + seg * 32;
        *(u32x4*)kod = (u32x4){ko[0], ko[1], ko[2], ko[3]}; *(u32x4*)(kod + 16) = (u32x4){ko[4], ko[5], ko[6], ko[7]};
#pragma unroll
        for (int i = 0; i < 4; ++i) *(u32x4*)(lds + GL_VT + ((tid >> 3) + 64 * i) * GL_TSTR + (tid & 7) * 16) = vt[i];
    }
    __syncthreads();
    const unsigned char* va = lds + GL_VT + (32 * w + l31) * GL_TSTR + hi * 16;
    const bf16x8 v0 = *(const bf16x8*)(va), v1 = *(const bf16x8*)(va + 32), v2 = *(const bf16x8*)(va + 64), v3 = *(const bf16x8*)(va + 96);
    float* kvo = KV + (size_t)u * 32768 + (size_t)(w * 4) * 1024 + lane;
#pragma unroll
    for (int kb = 0; kb < 4; ++kb) {
        f32x16 S;
#pragma unroll
        for (int r = 0; r < 16; ++r) S[r] = 0.f;
        const unsigned char* ko = lds + GL_KOUT + (32 * kb + l31) * GL_TSTR + hi * 16;
        S = MFMA32(*(const bf16x8*)(ko), v0, S); S = MFMA32(*(const bf16x8*)(ko + 32), v1, S);
        S = MFMA32(*(const bf16x8*)(ko + 64), v2, S); S = MFMA32(*(const bf16x8*)(ko + 96), v3, S);
#pragma unroll
        for (int r = 0; r < 16; ++r) kvo[(kb * 16 + r) * 64] = S[r];
    }
}

__device__ __forceinline__ void gla_scan(const float* __restrict__ KV, const float* __restrict__ DECb, u32x4* __restrict__ SP, int g) {
    const int lane = g & 63, s = (g >> 6) & 1, kb = (g >> 7) & 3, w = (g >> 9) & 7, bh = g >> 12, hi = lane >> 5;
    const float* kv = KV + (size_t)(bh * NCHUNK) * 32768 + (size_t)((w * 4 + kb) * 16 + 8 * s) * 64 + lane;
    const float* dc = DECb + (size_t)(bh * NCHUNK) * 128 + 32 * kb + 16 * s + 4 * hi;
    u32x4* sp = SP + (size_t)(bh * NCHUNK) * 4096 + ((w * 4 + kb) * 2 + s) * 64 + lane;
    float S[8];
#pragma unroll
    for (int j = 0; j < 8; ++j) S[j] = 0.f;
#pragma unroll 3
    for (int n = 0; n < NCHUNK; ++n) {
        float t[8];
#pragma unroll
        for (int j = 0; j < 8; ++j) t[j] = kv[(size_t)n * 32768 + j * 64];
        const f32x4 d0 = *(const f32x4*)(dc + (size_t)n * 128), d1 = *(const f32x4*)(dc + (size_t)n * 128 + 8);
        sp[(size_t)n * 4096] = (u32x4){pack2(S[0], S[1]), pack2(S[2], S[3]), pack2(S[4], S[5]), pack2(S[6], S[7])};
        S[0] = S[0] * d0.x + t[0]; S[1] = S[1] * d0.y + t[1]; S[2] = S[2] * d0.z + t[2]; S[3] = S[3] * d0.w + t[3];
        S[4] = S[4] * d1.x + t[4]; S[5] = S[5] * d1.y + t[5]; S[6] = S[6] * d1.z + t[6]; S[7] = S[7] * d1.w + t[7];
    }
}

__device__ __forceinline__ void gla_m3(unsigned char* lds, const bf16_t* __restrict__ P, const bf16_t* __restrict__ Vt, const u32x4* __restrict__ SP, bf16_t* __restrict__ OC,
                                       const float* __restrict__ w2, const float* __restrict__ b2, const float* __restrict__ ng, int u) {
    int tid_ = threadIdx.x; asm volatile("" : "+v"(tid_));
    const int tid = tid_, lane = tid & 63, w = __builtin_amdgcn_readfirstlane(tid >> 6), l31 = lane & 31, hi = lane >> 5;
    const int bh = u / NCHUNK, n = u - bh * NCHUNK, b = bh >> 2, h = bh & 3;
    const int d = tid & 127, seg = tid >> 7;
    float w2r[16];
#pragma unroll
    for (int j = 0; j < 16; ++j) w2r[j] = w2[(size_t)j * 512 + h * 128 + d];
    const float b2r = b2[h * 128 + d];
    float* LR = (float*)(lds + GL_LR); float* SEG = (float*)(lds + GL_SEG); float* NG = (float*)(lds + GL_NG);
    if (tid < 256) NG[tid] = ng[tid];
    const int dpos = swap23(d);
    const int tok8 = tid >> 3, part = tid & 7;
    const size_t R0 = (size_t)b * LP + 64 * n;
    const unsigned lrw = *(const unsigned*)(P + (R0 + tok8) * INP + 6144 + 2 * part);
    { const bf16_t* qp = P + (R0 + (tid >> 4)) * INP + 3072 + h * 128 + (tid & 15) * 8;
      const u32x4 q0 = *(const u32x4*)qp, q1 = *(const u32x4*)(qp + (size_t)32 * INP), k0 = *(const u32x4*)(qp + 512), k1 = *(const u32x4*)(qp + (size_t)32 * INP + 512);
      unsigned char* rq = lds + GL_RAWQ + (tid >> 4) * 256 + (tid & 15) * 16;
      *(u32x4*)rq = q0; *(u32x4*)(rq + 32 * 256) = q1; *(u32x4*)(rq + 16384) = k0; *(u32x4*)(rq + 16384 + 32 * 256) = k1; }
    u32x4 vt[4];
    { const bf16_t* vp = Vt + ((size_t)b * 1024 + h * 256 + (tid >> 3)) * LP + 64 * n + (tid & 7) * 8;
#pragma unroll
      for (int i = 0; i < 4; ++i) vt[i] = *(const u32x4*)(vp + (size_t)(64 * i) * LP); }
    LR[tok8 * 16 + 2 * part] = bflo(lrw); LR[tok8 * 16 + 2 * part + 1] = bfhi(lrw);
    __syncthreads();
    GL_GATE()
    {
#pragma unroll
        for (int i = 0; i < 16; i += 2) {
            const float b0 = bc[i] + off, b1 = bc[i + 1] + off;
            const bf16_t* rq = (const bf16_t*)(lds + GL_RAWQ + (16 * seg + i) * 256) + d;
            const float q0 = bf2f(rq[0]) * __expf(b0) * 0.08838834764831845f, q1 = bf2f(rq[128]) * __expf(b1) * 0.08838834764831845f;
            const float k0 = bf2f(rq[8192]), k1 = bf2f(rq[8192 + 128]);
            const unsigned qq = pack2(q0, q1), kk = pack2(k0 * __expf(-b0), k1 * __expf(-b1));
            bf16_t* qd = (bf16_t*)(lds + GL_QIN + (16 * seg + i) * GL_QSTR) + dpos; bf16_t* kd = (bf16_t*)(lds + GL_KIN + (16 * seg + i) * GL_QSTR) + dpos;
            qd[0] = (bf16_t)(qq & 0xffffu); qd[GL_QSTR / 2] = (bf16_t)(qq >> 16); kd[0] = (bf16_t)(kk & 0xffffu); kd[GL_QSTR / 2] = (bf16_t)(kk >> 16);
        }
#pragma unroll
        for (int i = 0; i < 4; ++i) *(u32x4*)(lds + GL_VT + ((tid >> 3) + 64 * i) * GL_TSTR + (tid & 7) * 16) = vt[i];
    }
    u32x4 sp[8];
    { const u32x4* spp = SP + (size_t)u * 4096 + (size_t)(w * 8) * 64 + lane;
#pragma unroll
      for (int i = 0; i < 8; ++i) sp[i] = spp[i * 64]; }
    __syncthreads();
    f32x16 X00, X01, X11;
#pragma unroll
    for (int r = 0; r < 16; ++r) { X00[r] = 0.f; X01[r] = 0.f; X11[r] = 0.f; }
    {
        const unsigned char* ka = lds + GL_KIN + swap23(l31) * GL_QSTR + hi * 16;
        const unsigned char* qa = lds + GL_QIN + l31 * GL_QSTR + hi * 16;
#pragma unroll 2
        for (int ks = 0; ks < 8; ++ks) {
            const bf16x8 k0 = *(const bf16x8*)(ka + ks * 32), k1 = *(const bf16x8*)(ka + 32 * GL_QSTR + ks * 32);
            const bf16x8 q0 = *(const bf16x8*)(qa + ks * 32), q1 = *(const bf16x8*)(qa + 32 * GL_QSTR + ks * 32);
            X00 = MFMA32(k0, q0, X00); X01 = MFMA32(k0, q1, X01); X11 = MFMA32(k1, q1, X11);
        }
#pragma unroll
        for (int r = 0; r < 16; ++r) { const int j = 16 * (r >> 3) + 8 * hi + (r & 7); if (j > l31) { X00[r] = 0.f; X11[r] = 0.f; } }
    }
    f32x16 Oa, Ob; u32x4 go[4];
#pragma unroll
    for (int r = 0; r < 16; ++r) { Oa[r] = 0.f; Ob[r] = 0.f; }
    {
        const unsigned char* va = lds + GL_VT + (32 * w + l31) * GL_TSTR + hi * 16;
        const bf16x8 v0 = *(const bf16x8*)(va), v1 = *(const bf16x8*)(va + 32), v2 = *(const bf16x8*)(va + 64), v3 = *(const bf16x8*)(va + 96);
        Oa = MFMA32(pack8(X00, 0), v0, Oa); Oa = MFMA32(pack8(X00, 1), v1, Oa);
        Ob = MFMA32(pack8(X01, 0), v0, Ob); Ob = MFMA32(pack8(X01, 1), v1, Ob);
        Ob = MFMA32(pack8(X11, 0), v2, Ob); Ob = MFMA32(pack8(X11, 1), v3, Ob);
        { const bf16_t* gp = P + (R0 + tok8) * INP + 5120 + h * 256 + 32 * part;
#pragma unroll
          for (int i = 0; i < 4; ++i) go[i] = *(const u32x4*)(gp + 8 * i); }
        const unsigned char* qa = lds + GL_QIN + l31 * GL_QSTR + hi * 16;
#pragma unroll
        for (int kb = 0; kb < 4; ++kb)
#pragma unroll
            for (int s = 0; s < 2; ++s) {
                const bf16x8 sb = __builtin_bit_cast(bf16x8, sp[kb * 2 + s]);
                const bf16x8 q0 = *(const bf16x8*)(qa + kb * 64 + s * 32), q1 = *(const bf16x8*)(qa + 32 * GL_QSTR + kb * 64 + s * 32);
                Oa = MFMA32(q0, sb, Oa); Ob = MFMA32(q1, sb, Ob);
            }
    }
    __syncthreads();
    {
        float* ost = (float*)lds;
#pragma unroll
        for (int r = 0; r < 16; ++r) { ost[crow(r, hi) * GL_OSTR + 32 * w + l31] = Oa[r]; ost[(32 + crow(r, hi)) * GL_OSTR + 32 * w + l31] = Ob[r]; }
    }
    __syncthreads();
    {
        const float* orow = (const float*)lds + tok8 * GL_OSTR + 32 * part;
        f32x4 ov[8]; float ss = 0.f;
#pragma unroll
        for (int i = 0; i < 8; ++i) { ov[i] = *(const f32x4*)(orow + 4 * i); ss += (ov[i].x * ov[i].x + ov[i].y * ov[i].y) + (ov[i].z * ov[i].z + ov[i].w * ov[i].w); }
        ss += __shfl_xor(ss, 1); ss += __shfl_xor(ss, 2); ss += __shfl_xor(ss, 4);
        const float rs = rsqrtf(ss * (1.f / 256.f) + EPS);
        bf16_t* od = OC + (R0 + tok8) * DM + 1024 + h * 256 + 32 * part;
#pragma unroll
        for (int i = 0; i < 4; ++i) {
            unsigned ow[4];
#pragma unroll
            for (int q = 0; q < 4; ++q) {
                const int e = 8 * i + 2 * q; const f32x4 o4 = ov[e >> 2]; const float o0 = (e & 2) ? o4.z : o4.x, o1 = (e & 2) ? o4.w : o4.y;
                const float g0 = bflo(go[i][q]), g1 = bfhi(go[i][q]);
                ow[q] = pack2(o0 * rs * NG[32 * part + e] * (g0 / (1.f + __expf(-g0))), o1 * rs * NG[32 * part + e + 1] * (g1 / (1.f + __expf(-g1))));
            }
            *(u32x4*)(od + 8 * i) = (u32x4){ow[0], ow[1], ow[2], ow[3]};
        }
    }
}

constexpr int PTAB = 131072;
#ifndef RP_PRO
#define RP_PRO 1
#endif
#ifndef RP_MIX
#define RP_MIX 1
#endif
#ifndef RP_G3
#define RP_G3 1
#endif
#ifndef RP_G4
#define RP_G4 1
#endif
#ifndef RP_GLA
#define RP_GLA 1
#endif
#ifndef RP_ATT
#define RP_ATT 1
#endif
#ifndef RP_CONV
#define RP_CONV 1
#endif
enum { T_X = 0, T_META, T_PRE_MIX_G, T_W_IN, T_DA_LAMBDA, T_DA_SUBLN_G, T_GATE_W2, T_GATE_B, T_GLA_NORM_G, T_W_OUT, T_POST_MIX_G, T_PRE_FFN_G, T_W_UP, T_CONV_W, T_CONV_B, T_W_DOWN, T_POST_FFN_G, T_OUT, T_WS, T_N };
__device__ __forceinline__ unsigned long long ldp_(const unsigned char* lds, int i) {
    const unsigned long long v = ((const volatile unsigned long long*)(lds + PTAB))[i];
    const unsigned lo = __builtin_amdgcn_readfirstlane((unsigned)v), hi = __builtin_amdgcn_readfirstlane((unsigned)(v >> 32));
    return ((unsigned long long)hi << 32) | lo;
}
#define LDF(i) ((const float*)ldp_(lds, (i)))
#define LDWS() ((unsigned char*)ldp_(lds, T_WS))
__global__ void __launch_bounds__(NTHR) hymba_fwd(Params p) {
    extern __shared__ __attribute__((aligned(16))) unsigned char lds[];
    cg::grid_group grid = cg::this_grid();
    if (threadIdx.x == 0) {
        unsigned long long* tab = (unsigned long long*)(lds + PTAB);
        tab[T_X] = (unsigned long long)p.x; tab[T_META] = (unsigned long long)p.meta; tab[T_PRE_MIX_G] = (unsigned long long)p.pre_mix_g; tab[T_W_IN] = (unsigned long long)p.w_in;
        tab[T_DA_LAMBDA] = (unsigned long long)p.da_lambda; tab[T_DA_SUBLN_G] = (unsigned long long)p.da_subln_g; tab[T_GATE_W2] = (unsigned long long)p.gate_w2; tab[T_GATE_B] = (unsigned long long)p.gate_b;
        tab[T_GLA_NORM_G] = (unsigned long long)p.gla_norm_g; tab[T_W_OUT] = (unsigned long long)p.w_out; tab[T_POST_MIX_G] = (unsigned long long)p.post_mix_g; tab[T_PRE_FFN_G] = (unsigned long long)p.pre_ffn_g;
        tab[T_W_UP] = (unsigned long long)p.w_up; tab[T_CONV_W] = (unsigned long long)p.conv_w; tab[T_CONV_B] = (unsigned long long)p.conv_b; tab[T_W_DOWN] = (unsigned long long)p.w_down;
        tab[T_POST_FFN_G] = (unsigned long long)p.post_ffn_g; tab[T_OUT] = (unsigned long long)p.out; tab[T_WS] = (unsigned long long)p.ws;
    }
    __syncthreads();
    const int lo = p.ph_lo, hi_ = p.ph_hi; const bool multi = (hi_ - lo) > 1;
    int ph = 0;
#define IN_PH() (ph >= lo && ph < hi_)
#define SEAM() do { ++ph; if (multi) grid.sync(); } while (0)
#define PH_VARS() int tid_ = threadIdx.x; asm volatile("" : "+v"(tid_)); int bx = blockIdx.x; asm volatile("" : "+s"(bx)); const int G = gridDim.x; \
    const int tid = tid_, lane = tid & 63, wave = __builtin_amdgcn_readfirstlane(tid >> 6); const int gw = bx * NWAVE + wave, ngw = G * NWAVE; \
    unsigned char* ws = LDWS(); LAS unsigned char* ldsa = (LAS unsigned char*)lds; (void)lane; (void)gw; (void)ngw; (void)ldsa; (void)ws

#ifndef NO_PRO
    for (int rp = 0; rp < RP_PRO; ++rp) if (IN_PH()) {
        PH_VARS();
        LAS float* scr = (LAS float*)(ldsa + wave * 16384);
        constexpr int NB_IN = INP / 32, NB_D = DM / 32, NB_UP = DFF2 / 32;
        constexpr int I_IN = (DM / 64) * NB_IN, I_OUT = (DM / 64) * NB_D, I_UP = (DM / 64) * NB_UP, I_DN = (DFF / 64) * NB_D, I_L = I_IN + I_OUT + I_UP + I_DN;
        for (int it = gw; it < DEPTH * I_L; it += ngw) {
            const int l = it / I_L; int r = it - l * I_L;
            if (r < I_IN) { transpose_item(LDF(T_W_IN) + (size_t)l * DM * INC, DM, INC, (bf16_t*)(ws + WS_WIN) + (size_t)l * INP * DM, scr, r, NB_IN, lane); continue; } r -= I_IN;
            if (r < I_OUT) { transpose_item(LDF(T_W_OUT) + (size_t)l * DM * DM, DM, DM, (bf16_t*)(ws + WS_WOUT) + (size_t)l * DM * DM, scr, r, NB_D, lane); continue; } r -= I_OUT;
            if (r < I_UP) { transpose_item(LDF(T_W_UP) + (size_t)l * DM * DFF2, DM, DFF2, (bf16_t*)(ws + WS_WUP) + (size_t)l * DFF2 * DM, scr, r, NB_UP, lane); continue; } r -= I_UP;
            transpose_item(LDF(T_W_DOWN) + (size_t)l * DFF * DM, DFF, DM, (bf16_t*)(ws + WS_WDN) + (size_t)l * DM * DFF, scr, r, NB_D, lane);
        }
        row_phase<0>(LDF(T_X), LDF(T_META), nullptr, (float*)(ws + WS_X), nullptr, (bf16_t*)(ws + WS_H), nullptr, LDF(T_PRE_MIX_G), gw, ngw, lane);
    }
#endif
    SEAM();

    for (int l = 0; l < DEPTH; ++l) {
        if (IN_PH()) {
            PH_VARS();
            pg8::Gemm g{(bf16_t*)(ws + WS_H), (bf16_t*)(ws + WS_WIN) + (size_t)l * INP * DM, MP, INP, DM}; pg8::StaticOrder S; S.init(MP, INP, G, bx);
            pg8::EpiIn E{(bf16_t*)(ws + WS_P), INP, (bf16_t*)(ws + WS_VTA), (bf16_t*)(ws + WS_VTB), LP, 0.125f * 1.4426950408889634f};
#ifndef NO_G1
            pg8::gemm_phase<pg8::EpiIn, pg8::StaticOrder, true, true>(ldsa, g, S, E);
#endif
        }
        SEAM();
        for (int sub = 0; sub < 3; ++sub) {
            for (int rp = 0; rp < RP_MIX; ++rp) if (IN_PH()) {
                PH_VARS();
                const bf16_t* P = (const bf16_t*)(ws + WS_P); bf16_t* OC = (bf16_t*)(ws + WS_OC);
                if (sub == 1) {
                    if (tid < 256 && bx * 256 + tid < 65536) gla_scan((const float*)(ws + WS_KV), (const float*)(ws + WS_DEC), (u32x4*)(ws + WS_SP), bx * 256 + tid);
                } else {
                    if (sub == 0) { for (int u = G - 1 - bx; u < NGU; u += G) gla_m1(lds, P, (const bf16_t*)(ws + WS_VTB), (float*)(ws + WS_KV), (float*)(ws + WS_DEC), LDF(T_GATE_W2) + (size_t)l * 16 * 512, LDF(T_GATE_B) + (size_t)l * 512, u); }
                    else { for (int u = bx; u < NGU; u += G) gla_m3(lds, P, (const bf16_t*)(ws + WS_VTB), (const u32x4*)(ws + WS_SP), OC, LDF(T_GATE_W2) + (size_t)l * 16 * 512, LDF(T_GATE_B) + (size_t)l * 512, LDF(T_GLA_NORM_G) + (size_t)l * 256, u); }
                    __syncthreads();
                    float* subg = (float*)(lds + 80000); float* lamw = subg + 128;
                    const float lam_init = 0.8f - 0.6f * __expf(-0.3f * (float)l);
                    if (tid < 128) subg[tid] = LDF(T_DA_SUBLN_G)[(size_t)l * 128 + tid];
                    if (wave == 0) { const float* lv = LDF(T_DA_LAMBDA) + (size_t)l * 256; const float a = wave_sum(lv[lane] * lv[64 + lane]), c2 = wave_sum(lv[128 + lane] * lv[192 + lane]);
                        if (lane == 0) lamw[0] = __expf(a) - __expf(c2) + lam_init; }
                    __syncthreads();
                    const float lam = lamw[0];
                    for (int ra = 0; ra < RP_ATT; ++ra) for (int k = (sub == 0 ? 0 : 1); k * G < 544 && (sub != 0 || k < 1); ++k) {
                        const int j = k * G + ((k & 1) ? (G - 1 - bx) : bx);
                        if (j < 544) attn_unit(lds, P, (const bf16_t*)(ws + WS_VTA), OC, subg, (j & 31) >> 3, j & 7, 16 - (j >> 5), lam, 1.f - lam_init);
                    }
                }
            }
            SEAM();
        }
        if (IN_PH()) {
            PH_VARS();
            pg8::Gemm g{(bf16_t*)(ws + WS_OC), (bf16_t*)(ws + WS_WOUT) + (size_t)l * DM * DM, MP, DM, DM}; pg8::StaticOrder S; S.init(MP, DM, G, bx);
            pg8::EpiF32 E{(float*)(ws + WS_Y), DM};
#ifndef NO_G2
            pg8::gemm_phase<pg8::EpiF32, pg8::StaticOrder, true, true>(ldsa, g, S, E);
#endif
        }
        SEAM();
#ifndef NO_ROW
        if (IN_PH()) { PH_VARS(); row_phase<1>(nullptr, nullptr, nullptr, (float*)(ws + WS_X), (const float*)(ws + WS_Y), (bf16_t*)(ws + WS_H), LDF(T_POST_MIX_G) + (size_t)l * DM, LDF(T_PRE_FFN_G) + (size_t)l * DM, gw, ngw, lane); }
#endif
        SEAM();
        for (int rp = 0; rp < RP_G3; ++rp) if (IN_PH()) {
            PH_VARS();
            pg8::Gemm g{(bf16_t*)(ws + WS_H), (bf16_t*)(ws + WS_WUP) + (size_t)l * DFF2 * DM, MP, DFF2, DM}; pg8::StaticOrder S; S.init(MP, DFF2, G, bx);
            pg8::EpiB16 E{(bf16_t*)(ws + WS_U), DFF2};
#ifndef NO_G3
            pg8::gemm_phase<pg8::EpiB16, pg8::StaticOrder, true, true>(ldsa, g, S, E);
#endif
        }
        SEAM();
#ifndef NO_CONV
        for (int rp = 0; rp < RP_CONV; ++rp) if (IN_PH()) { PH_VARS(); conv_phase((const bf16_t*)(ws + WS_U), (bf16_t*)(ws + WS_G), LDF(T_CONV_W) + (size_t)l * 3 * DFF2, LDF(T_CONV_B) + (size_t)l * DFF2, bx * NTHR + tid, G * NTHR); }
#endif
        SEAM();
        for (int rp = 0; rp < RP_G4; ++rp) if (IN_PH()) {
            PH_VARS();
            pg8::Gemm g{(bf16_t*)(ws + WS_G), (bf16_t*)(ws + WS_WDN) + (size_t)l * DM * DFF, MP, DM, DFF}; pg8::StaticOrder S; S.init(MP, DM, G, bx);
            pg8::EpiF32 E{(float*)(ws + WS_Y), DM};
#ifndef NO_G4
            pg8::gemm_phase<pg8::EpiF32, pg8::StaticOrder, true, true>(ldsa, g, S, E);
#endif
        }
        SEAM();
#ifndef NO_ROW
        if (IN_PH()) {
            PH_VARS();
            if (l + 1 < DEPTH) row_phase<1>(nullptr, nullptr, nullptr, (float*)(ws + WS_X), (const float*)(ws + WS_Y), (bf16_t*)(ws + WS_H), LDF(T_POST_FFN_G) + (size_t)l * DM, LDF(T_PRE_MIX_G) + (size_t)(l + 1) * DM, gw, ngw, lane);
            else row_phase<2>(nullptr, nullptr, (float*)ldp_(lds, T_OUT), (float*)(ws + WS_X), (const float*)(ws + WS_Y), nullptr, LDF(T_POST_FFN_G) + (size_t)l * DM, nullptr, gw, ngw, lane);
        }
#endif
        if (l + 1 < DEPTH) SEAM(); else ++ph;
    }
#undef IN_PH
#undef SEAM
}
constexpr int N_PHASES = 1 + 10 * DEPTH;

#ifndef MULTI_LAUNCH
#define MULTI_LAUNCH 0
#endif
extern "C" void kernel_launch(void* const* d_in, const int* in_sizes, int n_in, void* d_out, int out_size, void* d_ws, size_t ws_size, hipStream_t stream) {
    static int grid = 0;
    if (grid == 0) {
        if (n_in != 17 || ws_size < WS_END) { fprintf(stderr, "kernel_launch: need 17 inputs and %zu bytes of workspace (got %d, %zu)\n", (size_t)WS_END, n_in, ws_size); grid = -1; return; }
        int dev = 0, cus = 0, per_cu = 0;
        hipGetDevice(&dev); hipDeviceGetAttribute(&cus, hipDeviceAttributeMultiprocessorCount, dev);
        if (hipFuncSetAttribute((const void*)hymba_fwd, hipFuncAttributeMaxDynamicSharedMemorySize, LDS_BYTES) != hipSuccess) { fprintf(stderr, "kernel_launch: hipFuncSetAttribute failed\n"); grid = -1; return; }
        if (hipOccupancyMaxActiveBlocksPerMultiprocessor(&per_cu, (const void*)hymba_fwd, NTHR, LDS_BYTES) != hipSuccess || per_cu < 1) { fprintf(stderr, "kernel_launch: occupancy query gave %d\n", per_cu); per_cu = 1; }
        (void)hipGetLastError();
        grid = cus * (per_cu > 1 ? 1 : per_cu);
        if (grid * 256 < 65536) { fprintf(stderr, "kernel_launch: grid %d too small for the GLA scan mapping\n", grid); grid = -1; return; }
    }
    if (grid < 0) return;
    Params p{};
    const float** pp = (const float**)&p;
    for (int i = 0; i < 17; ++i) pp[i] = (const float*)d_in[i];
    p.out = (float*)d_out; p.ws = (unsigned char*)d_ws;
#if MULTI_LAUNCH
    for (int ph = 0; ph < N_PHASES; ++ph) { p.ph_lo = ph; p.ph_hi = ph + 1; hipLaunchKernelGGL(hymba_fwd, dim3(grid), dim3(NTHR), LDS_BYTES, stream, p); }
#else
    p.ph_lo = 0; p.ph_hi = N_PHASES;
    void* args[] = {&p};
    hipError_t e = hipLaunchCooperativeKernel((const void*)hymba_fwd, dim3(grid), dim3(NTHR), args, LDS_BYTES, stream);
    if (e != hipSuccess) fprintf(stderr, "kernel_launch: cooperative launch failed: %s (grid %d)\n", hipGetErrorString(e), grid);
#endif
}
```

```cpp
#include <hip/hip_runtime.h>
#include <hip/hip_cooperative_groups.h>
#include <cstdio>
#include <cstdint>
namespace cg = cooperative_groups;
#define MULTI_LAUNCH 0

namespace pg8 {
#define PG8_LAS __attribute__((address_space(3)))
typedef unsigned short bf16_t;
typedef short bf16x8 __attribute__((ext_vector_type(8)));
typedef float f32x4 __attribute__((ext_vector_type(4)));
typedef unsigned u32x4 __attribute__((ext_vector_type(4)));
constexpr int BM = 256, BK = 64, HALF = 128, HTB = HALF * BK * 2  , STAGE_BYTES = 8 * HTB, NXCD = 8, WGM = 8;

__host__ __device__ __forceinline__ int lds_byte(int r, int c) { const int st = (r >> 4) * 2 + (c >> 5), rr = r & 15, cc = c & 31, ob = rr * 64 + cc * 2; return st * 1024 + (ob ^ (((ob >> 9) & 1) << 5)); }
__host__ __device__ __forceinline__ void stage_rc(int b, int& R, int& C) { const int st = b / 1024, sb = b % 1024, swz = sb ^ (((sb >> 9) & 1) << 5); R = (st >> 1) * 16 + swz / 64; C = (st & 1) * 32 + (swz % 64) / 2; }
__host__ __device__ __forceinline__ int perm32(int rho) { const int n = rho >> 4, i = rho & 15; return 8 * (i >> 2) + 4 * n + (i & 3); }

struct Unit { int pm, pn, koff; };
struct Gemm { const bf16_t* A; const bf16_t* Bt; int M, N, K, ld; };

struct StaticOrder {
    int nM, nN, nwg, G, c;
    __host__ __device__ void init(int M, int N, int G_, int c_) { nM = M / BM; nN = N / BM; nwg = nM * nN; G = G_; c = c_; }
    __host__ __device__ bool next(int i, Unit& u) const {
        const long L = (long)i * G + c; if (L >= nwg) return false;
        int wgid = (int)L; { const int q = nwg / NXCD, r = nwg % NXCD, xcd = wgid % NXCD, off = wgid / NXCD; wgid = (xcd < r ? xcd * (q + 1) : r * (q + 1) + (xcd - r) * q) + off; }
        const int nig = WGM * nN, gid = wgid / nig, fm = gid * WGM, gsz = (nM - fm) < WGM ? (nM - fm) : WGM;
        u.pm = fm + ((wgid % nig) % gsz); u.pn = (wgid % nig) / gsz; u.koff = 0; return true;
    }
    __device__ __forceinline__ void a_ready(const Unit&) const {}
    __device__ __forceinline__ void done(const Unit&) const {}
};
__device__ __forceinline__ unsigned cvt_pk_bf16(float lo, float hi) { unsigned r; asm volatile("v_cvt_pk_bf16_f32 %0, %1, %2" : "=v"(r) : "v"(lo), "v"(hi)); return r; }

struct EpiF32 {
    static constexpr bool PERM = false, AFTER_DRAIN = false;
    float* O; int ldc;
    __device__ __forceinline__ void operator()(const f32x4 (&acc)[2][2][4][2], const Unit& u, int wr, int wc, int fr, int fq) const {
        const int row0 = u.pm * BM + wr * 64 + fr, col0 = u.pn * BM + wc * 32 + 4 * fq;
#pragma unroll
        for (int ai = 0; ai < 2; ++ai)
#pragma unroll
            for (int m = 0; m < 4; ++m) { float* rowp = O + (size_t)(row0 + ai * HALF + m * 16) * ldc + col0;
#pragma unroll
                for (int bj = 0; bj < 2; ++bj)
#pragma unroll
                    for (int n = 0; n < 2; ++n) *(f32x4*)(rowp + bj * HALF + n * 16) = acc[ai][bj][m][n]; }
    }
};
struct EpiB16 {
    static constexpr bool PERM = true, AFTER_DRAIN = false;
    bf16_t* O; int ldc;
    __device__ __forceinline__ void operator()(const f32x4 (&acc)[2][2][4][2], const Unit& u, int wr, int wc, int fr, int fq) const {
        const int row0 = u.pm * BM + wr * 64 + fr, col0 = u.pn * BM + wc * 32 + 8 * fq;
#pragma unroll
        for (int ai = 0; ai < 2; ++ai)
#pragma unroll
            for (int m = 0; m < 4; ++m) { bf16_t* rowp = O + (size_t)(row0 + ai * HALF + m * 16) * ldc + col0;
#pragma unroll
                for (int bj = 0; bj < 2; ++bj) { const f32x4 v0 = acc[ai][bj][m][0], v1 = acc[ai][bj][m][1];
                    u32x4 w; w.x = cvt_pk_bf16(v0[0], v0[1]); w.y = cvt_pk_bf16(v0[2], v0[3]); w.z = cvt_pk_bf16(v1[0], v1[1]); w.w = cvt_pk_bf16(v1[2], v1[3]);
                    *(u32x4*)(rowp + bj * HALF) = w; } }
    }
};
struct EpiIn {
    static constexpr bool PERM = true, AFTER_DRAIN = false;
    bf16_t* P; int ldc; bf16_t* VtA; bf16_t* VtB; int LPtok; float qscale;
    __device__ __forceinline__ void operator()(const f32x4 (&acc)[2][2][4][2], const Unit& u, int wr, int wc, int fr, int fq) const {
        const int row0 = u.pm * BM + wr * 64 + fr, col0 = u.pn * BM + wc * 32 + 8 * fq;
        const bool isva = (u.pn >= 8 && u.pn < 12), isvb = (u.pn >= 16 && u.pn < 20);
        if (isva || isvb) {
            bf16_t* Vt = isva ? VtA : VtB; const int cbase = col0 - (isva ? 2048 : 4096);
#pragma unroll
            for (int ai = 0; ai < 2; ++ai)
#pragma unroll
                for (int m = 0; m < 4; ++m) { const int row = row0 + ai * HALF + m * 16; const int b = row / LPtok, t = row - b * LPtok;
#pragma unroll
                    for (int bj = 0; bj < 2; ++bj) { const f32x4 v0 = acc[ai][bj][m][0], v1 = acc[ai][bj][m][1];
                        const unsigned w0 = cvt_pk_bf16(v0[0], v0[1]), w1 = cvt_pk_bf16(v0[2], v0[3]), w2 = cvt_pk_bf16(v1[0], v1[1]), w3 = cvt_pk_bf16(v1[2], v1[3]);
                        bf16_t* dst = Vt + ((size_t)b * 1024 + cbase + bj * HALF) * LPtok + t;
                        dst[0] = (bf16_t)(w0 & 0xffffu); dst[(size_t)LPtok] = (bf16_t)(w0 >> 16); dst[(size_t)2 * LPtok] = (bf16_t)(w1 & 0xffffu); dst[(size_t)3 * LPtok] = (bf16_t)(w1 >> 16);
                        dst[(size_t)4 * LPtok] = (bf16_t)(w2 & 0xffffu); dst[(size_t)5 * LPtok] = (bf16_t)(w2 >> 16); dst[(size_t)6 * LPtok] = (bf16_t)(w3 & 0xffffu); dst[(size_t)7 * LPtok] = (bf16_t)(w3 >> 16); } }
        } else {
            const float sc = (u.pn < 4) ? qscale : 1.f;
#pragma unroll
            for (int ai = 0; ai < 2; ++ai)
#pragma unroll
                for (int m = 0; m < 4; ++m) { bf16_t* rowp = P + (size_t)(row0 + ai * HALF + m * 16) * ldc + col0;
#pragma unroll
                    for (int bj = 0; bj < 2; ++bj) { const f32x4 v0 = acc[ai][bj][m][0] * sc, v1 = acc[ai][bj][m][1] * sc;
                        u32x4 w; w.x = cvt_pk_bf16(v0[0], v0[1]); w.y = cvt_pk_bf16(v0[2], v0[3]); w.z = cvt_pk_bf16(v1[0], v1[1]); w.w = cvt_pk_bf16(v1[2], v1[3]);
                        *(u32x4*)(rowp + bj * HALF) = w; } }
        }
    }
};


struct EpiPart {
    static constexpr bool PERM = false, AFTER_DRAIN = false;
    float* O; int ldc; int kpiece;
    __device__ __forceinline__ void operator()(const f32x4 (&acc)[2][2][4][2], const Unit& u, int wr, int wc, int fr, int fq) const {
        const int row0 = wr * 64 + fr, col0 = u.pn * BM + wc * 32 + 4 * fq;
        float* base = O + (size_t)(u.koff / kpiece) * 256 * ldc;
#pragma unroll
        for (int ai = 0; ai < 2; ++ai)
#pragma unroll
            for (int m = 0; m < 4; ++m) { float* rowp = base + (size_t)(row0 + ai * HALF + m * 16) * ldc + col0;
#pragma unroll
                for (int bj = 0; bj < 2; ++bj)
#pragma unroll
                    for (int n = 0; n < 2; ++n) *(f32x4*)(rowp + bj * HALF + n * 16) = acc[ai][bj][m][n]; }
    }
};
struct FullOrder32 {
    int G, c;
    __device__ bool next(int i, Unit& u) const { const int L = c + i * G; if (L >= 256) return false; const int x = L & 7, off = L >> 3; u.pm = 4 * x + (off >> 3); u.pn = off & 7; u.koff = 0; return true; }
    __device__ __forceinline__ void a_ready(const Unit&) const {}
    __device__ __forceinline__ void done(const Unit&) const {}
};
struct SplitOrder32 {
    int G, c, nsplit, kpiece;
    __device__ bool next(int i, Unit& u) const { const int q = c + i * G; if (q >= 8 * nsplit) return false; u.pm = 32; u.pn = q & 7; u.koff = (q >> 3) * kpiece; return true; }
    __device__ __forceinline__ void a_ready(const Unit&) const {}
    __device__ __forceinline__ void done(const Unit&) const {}
};
template <class Epi, class Sched, bool ALIGN_EPI = false, bool SP2 = false>
__device__ __forceinline__ void gemm_phase(PG8_LAS unsigned char* lds, const Gemm g, const Sched& S, const Epi& E) {
    int tid_ = threadIdx.x; asm volatile("" : "+v"(tid_));
    const int tid = tid_, wid = __builtin_amdgcn_readfirstlane(tid >> 6), lane = tid & 63, wr = wid >> 2, wc = wid & 3, fr = lane & 15, fq = lane >> 4;
    const int K = g.K, nt = K / BK, LD = g.ld ? g.ld : g.K;
    unsigned voffA[2], voffB[2];
#pragma unroll
    for (int i = 0; i < 2; ++i) { int R, C; stage_rc(tid * 16 + i * 8192, R, C); const int Rb = Epi::PERM ? ((R & ~31) + perm32(R & 31)) : R;
        voffA[i] = (unsigned)(R * LD + C) * 2u; voffB[i] = (unsigned)(Rb * LD + C) * 2u; }
    const size_t kstep = (size_t)(BK * 2);
    const size_t hstep = (size_t)HALF * LD * 2;
    const size_t tstep = 2 * hstep;
    const unsigned ldsw = (unsigned)wid * 1024u;
    const int aoff = lds_byte(wr * 64 + fr, fq * 8), boff = lds_byte(wc * 32 + fr, fq * 8);
#define PG8_SA(b, h) (((b) * 2 + (h)) * HTB)
#define PG8_SB(b, h) ((4 + (b) * 2 + (h)) * HTB)
#define PG8_STAGE(bufoff, gbase, voff) do { _Pragma("unroll") for (int _i = 0; _i < 2; ++_i) \
        __builtin_amdgcn_global_load_lds((const unsigned*)((const char*)(gbase) + (voff)[_i]), (PG8_LAS unsigned*)(lds + (bufoff) + ldsw + _i * 8192), 16, 0, 0); } while (0)
#define PG8_LDA(dst, b, h) do { _Pragma("unroll") for (int m = 0; m < 4; ++m) _Pragma("unroll") for (int k = 0; k < 2; ++k) dst[m][k] = *(const PG8_LAS bf16x8*)(lds + PG8_SA(b, h) + aoff + m * 2048 + k * 1024); } while (0)
#define PG8_LDB(dst, b, h) do { _Pragma("unroll") for (int n = 0; n < 2; ++n) _Pragma("unroll") for (int k = 0; k < 2; ++k) dst[n][k] = *(const PG8_LAS bf16x8*)(lds + PG8_SB(b, h) + boff + n * 2048 + k * 1024); } while (0)
#define PG8_MMA(ai, bj, At, Bt) do { __builtin_amdgcn_s_setprio(1); _Pragma("unroll") for (int m = 0; m < 4; ++m) _Pragma("unroll") for (int n = 0; n < 2; ++n) _Pragma("unroll") for (int k = 0; k < 2; ++k) \
        acc[ai][bj][m][n] = __builtin_amdgcn_mfma_f32_16x16x32_bf16(Bt[n][k], At[m][k], acc[ai][bj][m][n], 0, 0, 0); __builtin_amdgcn_s_setprio(0); } while (0)
#define PG8_WAIT_V(n) asm volatile("s_waitcnt vmcnt(" #n ")" ::: "memory")
#define PG8_WAIT_L(n) asm volatile("s_waitcnt lgkmcnt(" #n ")" ::: "memory")
#define PG8_BAR __builtin_amdgcn_s_barrier()
#define PG8_SCHED __builtin_amdgcn_sched_barrier(0)
    Unit cur, nxt; int ui = 0;
    if (!S.next(0, cur)) return;
    f32x4 acc[2][2][4][2];
#pragma unroll
    for (int a = 0; a < 2; ++a)
#pragma unroll
        for (int b = 0; b < 2; ++b)
#pragma unroll
            for (int m = 0; m < 4; ++m)
#pragma unroll
                for (int n = 0; n < 2; ++n) acc[a][b][m][n] = (f32x4){0.f, 0.f, 0.f, 0.f};
    bf16x8 At[4][2], B0[2][2], B1[2][2];
    const char* cA = (const char*)g.A + (size_t)cur.pm * tstep + (size_t)cur.koff * 2; const char* cB = (const char*)g.Bt + (size_t)cur.pn * tstep + (size_t)cur.koff * 2;
    S.a_ready(cur);
    if constexpr (SP2) {
        PG8_STAGE(PG8_SB(0, 0), cB, voffB); PG8_STAGE(PG8_SB(0, 1), cB + hstep, voffB); PG8_STAGE(PG8_SA(0, 0), cA, voffA); PG8_STAGE(PG8_SA(0, 1), cA + hstep, voffA);
        if (wr == 1) PG8_BAR;
        PG8_WAIT_V(2); PG8_BAR;
        PG8_STAGE(PG8_SB(1, 0), cB + kstep, voffB); PG8_STAGE(PG8_SA(1, 0), cA + kstep, voffA); PG8_STAGE(PG8_SB(1, 1), cB + hstep + kstep, voffB);
        PG8_WAIT_V(6); PG8_BAR;
    } else {
        PG8_STAGE(PG8_SB(0, 0), cB, voffB); PG8_STAGE(PG8_SA(0, 0), cA, voffA); PG8_STAGE(PG8_SB(0, 1), cB + hstep, voffB); PG8_STAGE(PG8_SA(0, 1), cA + hstep, voffA);
        if (wr == 1) PG8_BAR;
        PG8_WAIT_V(4); PG8_BAR;
        PG8_STAGE(PG8_SB(1, 0), cB + kstep, voffB); PG8_STAGE(PG8_SA(1, 0), cA + kstep, voffA); PG8_STAGE(PG8_SB(1, 1), cB + hstep + kstep, voffB);
        PG8_WAIT_V(6); PG8_BAR;
    }
    for (;;) {
        const bool has_next = S.next(ui + 1, nxt);
        const char* nA = has_next ? (const char*)g.A + (size_t)nxt.pm * tstep + (size_t)nxt.koff * 2 : cA; const char* nB = has_next ? (const char*)g.Bt + (size_t)nxt.pn * tstep + (size_t)nxt.koff * 2 : cB;
        for (int t = 0; t < nt; t += 2) {
            const bool last = (t == nt - 2);
            const char* a1 = cA + (size_t)(t + 1) * kstep;
            const char* a2 = last ? nA : cA + (size_t)(t + 2) * kstep; const char* b2 = last ? nB : cB + (size_t)(t + 2) * kstep;
            const char* a3 = a2 + kstep; const char* b3 = b2 + kstep;
            if (last && has_next) S.a_ready(nxt);
            if constexpr (SP2) {
            PG8_LDB(B0, 0, 0); PG8_LDB(B1, 0, 1); PG8_SCHED; PG8_LDA(At, 0, 0); PG8_STAGE(PG8_SA(1, 1), a1 + hstep, voffA);
            PG8_WAIT_V(8); PG8_WAIT_L(0); PG8_BAR; PG8_MMA(0, 0, At, B0); PG8_MMA(0, 1, At, B1); PG8_BAR; PG8_SCHED;
            PG8_LDA(At, 0, 1); PG8_STAGE(PG8_SB(0, 0), b2, voffB); PG8_STAGE(PG8_SB(0, 1), b2 + hstep, voffB); PG8_STAGE(PG8_SA(0, 0), a2, voffA);
            PG8_WAIT_V(8); PG8_WAIT_L(0); PG8_BAR; PG8_MMA(1, 0, At, B0); PG8_MMA(1, 1, At, B1); PG8_BAR; PG8_SCHED;
            PG8_LDB(B0, 1, 0); PG8_LDB(B1, 1, 1); PG8_SCHED; PG8_LDA(At, 1, 0); PG8_STAGE(PG8_SA(0, 1), a2 + hstep, voffA);
            PG8_WAIT_V(8); PG8_WAIT_L(0); PG8_BAR; PG8_MMA(0, 0, At, B0); PG8_MMA(0, 1, At, B1); PG8_BAR; PG8_SCHED;
            PG8_LDA(At, 1, 1); PG8_STAGE(PG8_SB(1, 0), b3, voffB); PG8_STAGE(PG8_SB(1, 1), b3 + hstep, voffB); PG8_STAGE(PG8_SA(1, 0), a3, voffA);
            PG8_WAIT_V(8); PG8_WAIT_L(0); PG8_BAR; PG8_MMA(1, 0, At, B0); PG8_MMA(1, 1, At, B1); PG8_BAR; PG8_SCHED;
            } else {
            PG8_LDB(B0, 0, 0); PG8_SCHED; PG8_LDA(At, 0, 0); PG8_STAGE(PG8_SA(1, 1), a1 + hstep, voffA);
            PG8_WAIT_L(8); PG8_BAR; PG8_WAIT_L(0); PG8_MMA(0, 0, At, B0); PG8_BAR; PG8_SCHED;
            PG8_LDB(B1, 0, 1); PG8_STAGE(PG8_SB(0, 0), b2, voffB);
            PG8_BAR; PG8_WAIT_L(0); PG8_MMA(0, 1, At, B1); PG8_BAR;
            PG8_LDA(At, 0, 1); PG8_STAGE(PG8_SA(0, 0), a2, voffA);
            PG8_BAR; PG8_WAIT_L(0); PG8_MMA(1, 0, At, B0); PG8_BAR; PG8_SCHED;
            PG8_STAGE(PG8_SB(0, 1), b2 + hstep, voffB);
            PG8_WAIT_V(6); PG8_BAR; PG8_MMA(1, 1, At, B1); PG8_BAR;
            PG8_LDB(B0, 1, 0); PG8_SCHED; PG8_LDA(At, 1, 0); PG8_STAGE(PG8_SA(0, 1), a2 + hstep, voffA);
            PG8_WAIT_L(8); PG8_BAR; PG8_WAIT_L(0); PG8_MMA(0, 0, At, B0); PG8_BAR; PG8_SCHED;
            PG8_LDB(B1, 1, 1); PG8_STAGE(PG8_SB(1, 0), b3, voffB);
            PG8_BAR; PG8_WAIT_L(0); PG8_MMA(0, 1, At, B1); PG8_BAR;
            PG8_LDA(At, 1, 1); PG8_STAGE(PG8_SA(1, 0), a3, voffA);
            PG8_BAR; PG8_WAIT_L(0); PG8_MMA(1, 0, At, B0); PG8_BAR; PG8_SCHED;
            PG8_STAGE(PG8_SB(1, 1), b3 + hstep, voffB);
            PG8_WAIT_V(6); PG8_BAR; PG8_MMA(1, 1, At, B1); PG8_BAR;
            }
        }
        if constexpr (ALIGN_EPI) { if (wr == 0) PG8_BAR; }
        if constexpr (!Epi::AFTER_DRAIN) { E(acc, cur, wr, wc, fr, fq); S.done(cur); }
        if (!has_next) break;
#pragma unroll
        for (int a = 0; a < 2; ++a)
#pragma unroll
            for (int b = 0; b < 2; ++b)
#pragma unroll
                for (int m = 0; m < 4; ++m)
#pragma unroll
                    for (int n = 0; n < 2; ++n) acc[a][b][m][n] = (f32x4){0.f, 0.f, 0.f, 0.f};
        cur = nxt; cA = nA; cB = nB; ++ui;
        if constexpr (ALIGN_EPI) { if (wr == 1) PG8_BAR; }
    }
    PG8_WAIT_V(0);
    if constexpr (!ALIGN_EPI) { if (wr == 0) PG8_BAR; }
    PG8_BAR;
    if constexpr (Epi::AFTER_DRAIN) { E.fused(acc, cur, wr, wc, fr, fq, lds, wid, lane); S.done(cur); }
#undef PG8_SA
#undef PG8_SB
#undef PG8_STAGE
#undef PG8_LDA
#undef PG8_LDB
#undef PG8_MMA
#undef PG8_WAIT_V
#undef PG8_WAIT_L
#undef PG8_BAR
#undef PG8_SCHED
}
}

#define LAS __attribute__((address_space(3)))
typedef unsigned short bf16_t;
typedef short bf16x8 __attribute__((ext_vector_type(8)));
typedef float f32x4 __attribute__((ext_vector_type(4)));
typedef float f32x16 __attribute__((ext_vector_type(16)));
typedef unsigned u32x4 __attribute__((ext_vector_type(4)));
typedef unsigned u32x2 __attribute__((ext_vector_type(2)));
typedef float f32x2_t __attribute__((ext_vector_type(2)));
typedef __bf16 bf16x2_t __attribute__((ext_vector_type(2)));

constexpr int DM = 2048, NB = 4, SEQ = 2048, DEPTH = 4, NMETA = 16;
constexpr int LT = SEQ + NMETA;
constexpr int LP = 2112;
constexpr int MP = NB * LP;
constexpr int INC = 6160, INP = 6400;
constexpr int DFF = 5632, DFF2 = 11264;
constexpr float EPS = 1e-6f;
constexpr int NTHR = 512, NWAVE = 8;
constexpr int LDS_BYTES = 135168;

constexpr size_t al256(size_t x) { return (x + 255) & ~(size_t)255; }
constexpr size_t SZ_WIN = (size_t)INP * DM * 2, SZ_WOUT = (size_t)DM * DM * 2, SZ_WUP = (size_t)DFF2 * DM * 2, SZ_WDN = (size_t)DM * DFF * 2;
constexpr size_t WS_WIN = 0;
constexpr size_t WS_WOUT = WS_WIN + DEPTH * SZ_WIN;
constexpr size_t WS_WUP = WS_WOUT + DEPTH * SZ_WOUT;
constexpr size_t WS_WDN = WS_WUP + DEPTH * SZ_WUP;
constexpr size_t WS_X = WS_WDN + DEPTH * SZ_WDN;
constexpr size_t WS_H = WS_X + (size_t)MP * DM * 4;
constexpr size_t WS_P = WS_H + (size_t)MP * DM * 2;
constexpr size_t WS_VTA = WS_P + (size_t)MP * INP * 2;
constexpr size_t WS_VTB = WS_VTA + al256((size_t)NB * 1024 * LP * 2 + 4096);
constexpr size_t WS_OC = WS_VTB + al256((size_t)NB * 1024 * LP * 2 + 4096);
constexpr size_t WS_Y = WS_OC + (size_t)MP * DM * 2;
constexpr size_t WS_U = WS_Y + (size_t)MP * DM * 4;
constexpr size_t WS_G = WS_U + (size_t)MP * DFF2 * 2;
constexpr size_t WS_KV = WS_G + (size_t)MP * DFF * 2;
constexpr size_t WS_SP = WS_KV + (size_t)528 * 32768 * 4;
constexpr size_t WS_DEC = WS_SP + (size_t)528 * 65536;
constexpr size_t WS_PART = WS_DEC + (size_t)528 * 128 * 4;
constexpr size_t WS_CTL = WS_PART + (size_t)22 * 256 * DM * 4;
constexpr size_t CTL_BYTES = 16384;
constexpr size_t WS_END = WS_CTL + CTL_BYTES;

struct Params {
    const float *x, *meta, *pre_mix_g, *w_in, *da_lambda, *da_subln_g, *gate_w2, *gate_b, *gla_norm_g, *w_out, *post_mix_g, *pre_ffn_g, *w_up, *conv_w, *conv_b, *w_down, *post_ffn_g;
    float* out; unsigned char* ws; int ph_lo, ph_hi;
};

__device__ __forceinline__ unsigned pack2(float lo, float hi) { f32x2_t v = {lo, hi}; bf16x2_t b = __builtin_convertvector(v, bf16x2_t); return __builtin_bit_cast(unsigned, b); }
__device__ __forceinline__ float bf2f(unsigned short u) { return __uint_as_float(((unsigned)u) << 16); }
__device__ __forceinline__ float bflo(unsigned u) { return __uint_as_float(u << 16); }
__device__ __forceinline__ float bfhi(unsigned u) { return __uint_as_float(u & 0xffff0000u); }
__device__ __forceinline__ float wave_sum(float v) {
#pragma unroll
    for (int o = 1; o < 64; o <<= 1) v += __shfl_xor(v, o);
    return v;
}
#define MFMA32(a, b, c) __builtin_amdgcn_mfma_f32_32x32x16_bf16((a), (b), (c), 0, 0, 0)
__device__ __forceinline__ bf16x8 pack8(const f32x16& x, int s) {
    u32x4 p; p.x = pack2(x[8 * s + 0], x[8 * s + 1]); p.y = pack2(x[8 * s + 2], x[8 * s + 3]); p.z = pack2(x[8 * s + 4], x[8 * s + 5]); p.w = pack2(x[8 * s + 6], x[8 * s + 7]);
    return __builtin_bit_cast(bf16x8, p);
}
__device__ __forceinline__ int swap23(int i) { return (i & ~12) | ((i & 4) << 1) | ((i & 8) >> 1); }
__device__ __forceinline__ int crow(int r, int hi) { return (r & 3) + 8 * (r >> 2) + 4 * hi; }

struct TItem { const float* W; bf16_t* WT; int K, Nsrc, k0, n0; };
__device__ __forceinline__ void titem_load(const TItem& ti, float (&r)[32], int lane) {
    const int n = ti.n0 + (lane & 31); const bool ok = n < ti.Nsrc;
    const float* src = ti.W + (size_t)(ti.k0 + (lane >> 5)) * ti.Nsrc + n;
#pragma unroll
    for (int i = 0; i < 32; ++i) r[i] = ok ? src[(size_t)(2 * i) * ti.Nsrc] : 0.f;
}
__device__ __forceinline__ void titem_store(const TItem& ti, const float (&r)[32], LAS float* scr, int lane) {
#pragma unroll
    for (int i = 0; i < 32; ++i) scr[(2 * i + (lane >> 5)) * 33 + (lane & 31)] = r[i];
    asm volatile("s_waitcnt lgkmcnt(0)" ::: "memory");
    const int c = lane & 7;
#pragma unroll
    for (int j = 0; j < 4; ++j) { const int nn = (lane >> 3) + 8 * j; const LAS float* s = scr + (8 * c) * 33 + nn;
        u32x4 o; o.x = pack2(s[0 * 33], s[1 * 33]); o.y = pack2(s[2 * 33], s[3 * 33]); o.z = pack2(s[4 * 33], s[5 * 33]); o.w = pack2(s[6 * 33], s[7 * 33]);
        *(u32x4*)(ti.WT + (size_t)(ti.n0 + nn) * ti.K + ti.k0 + 8 * c) = o; }
    asm volatile("s_waitcnt lgkmcnt(0)" ::: "memory");
}

template <int MODE>
__device__ __forceinline__ void row_phase(const float* xin, const float* meta, float* outp, float* X, const float* Y, const float* PART, int nsplit, bf16_t* H, const float* g1, const float* g2, int gw, int ngw, int lane) {
    for (int row = gw; row < MP; row += ngw) {
        const int b = row / LP, t = row - b * LP;
        f32x4 xv[8];
        float* xr = X + (size_t)row * DM;
        if (MODE == 0) {
            const float* src = (t < NMETA) ? meta + (size_t)t * DM : xin + ((size_t)b * SEQ + (t - NMETA)) * DM;
#pragma unroll
            for (int j = 0; j < 8; ++j) xv[j] = (t < LT) ? *(const f32x4*)(src + 4 * (lane + 64 * j)) : (f32x4){0.f, 0.f, 0.f, 0.f};
        } else {
            const float* yr = Y + (size_t)row * DM;
            f32x4 yv[8]; float ss = 0.f;
            if (row >= 8192) {
#pragma unroll
                for (int j = 0; j < 8; ++j) yv[j] = (f32x4){0.f, 0.f, 0.f, 0.f};
                for (int kp = 0; kp < nsplit; ++kp) { const float* pr = PART + ((size_t)kp * 256 + (row - 8192)) * DM;
#pragma unroll
                    for (int j = 0; j < 8; ++j) yv[j] += *(const f32x4*)(pr + 4 * (lane + 64 * j)); }
            } else {
#pragma unroll
                for (int j = 0; j < 8; ++j) yv[j] = *(const f32x4*)(yr + 4 * (lane + 64 * j));
            }
#pragma unroll
            for (int j = 0; j < 8; ++j) { ss += (yv[j].x * yv[j].x + yv[j].y * yv[j].y) + (yv[j].z * yv[j].z + yv[j].w * yv[j].w); }
            const float r1 = rsqrtf(wave_sum(ss) * (1.f / DM) + EPS);
#pragma unroll
            for (int j = 0; j < 8; ++j) { const f32x4 g = *(const f32x4*)(g1 + 4 * (lane + 64 * j)); const f32x4 xo = *(const f32x4*)(xr + 4 * (lane + 64 * j)); xv[j] = xo + yv[j] * r1 * g; }
        }
        if (MODE == 2) {
            if (t >= NMETA && t < LT) { float* orow = outp + ((size_t)b * SEQ + (t - NMETA)) * DM;
#pragma unroll
                for (int j = 0; j < 8; ++j) *(f32x4*)(orow + 4 * (lane + 64 * j)) = xv[j]; }
        } else {
            float ss = 0.f;
#pragma unroll
            for (int j = 0; j < 8; ++j) { *(f32x4*)(xr + 4 * (lane + 64 * j)) = xv[j]; ss += (xv[j].x * xv[j].x + xv[j].y * xv[j].y) + (xv[j].z * xv[j].z + xv[j].w * xv[j].w); }
            const float r2 = rsqrtf(wave_sum(ss) * (1.f / DM) + EPS);
            bf16_t* hr = H + (size_t)row * DM;
#pragma unroll
            for (int j = 0; j < 8; ++j) { const f32x4 g = *(const f32x4*)(g2 + 4 * (lane + 64 * j)); const f32x4 v = xv[j] * r2 * g;
                u32x2 w; w.x = pack2(v.x, v.y); w.y = pack2(v.z, v.w); *(u32x2*)(hr + 4 * (lane + 64 * j)) = w; }
        }
    }
}

__device__ __forceinline__ void conv_phase(const bf16_t* U, bf16_t* G, const float* cw, const float* cb, int gtid, int ngt) {
    constexpr int NCG = DFF / 8, NSTRIP = MP / 16;
    for (int it = gtid; it < NCG * NSTRIP; it += ngt) {
        const int s = it / NCG, cgp = it - s * NCG, j0 = 8 * cgp, row0 = 16 * s; const int t0 = row0 % LP;
        float wa[3][8], wv[3][8], ba[8], bv[8];
#pragma unroll
        for (int i = 0; i < 3; ++i)
#pragma unroll
            for (int e = 0; e < 8; e += 4) { const f32x4 a = *(const f32x4*)(cw + (size_t)i * DFF2 + j0 + e), v = *(const f32x4*)(cw + (size_t)i * DFF2 + DFF + j0 + e);
                wa[i][e] = a.x; wa[i][e + 1] = a.y; wa[i][e + 2] = a.z; wa[i][e + 3] = a.w; wv[i][e] = v.x; wv[i][e + 1] = v.y; wv[i][e + 2] = v.z; wv[i][e + 3] = v.w; }
#pragma unroll
        for (int e = 0; e < 8; e += 4) { const f32x4 a = *(const f32x4*)(cb + j0 + e), v = *(const f32x4*)(cb + DFF + j0 + e);
            ba[e] = a.x; ba[e + 1] = a.y; ba[e + 2] = a.z; ba[e + 3] = a.w; bv[e] = v.x; bv[e + 1] = v.y; bv[e + 2] = v.z; bv[e + 3] = v.w; }
        u32x4 a2 = {0, 0, 0, 0}, a1 = {0, 0, 0, 0}, v2 = {0, 0, 0, 0}, v1 = {0, 0, 0, 0};
        if (t0 > 0) { const bf16_t* u = U + (size_t)(row0 - 2) * DFF2 + j0; a2 = *(const u32x4*)u; v2 = *(const u32x4*)(u + DFF); a1 = *(const u32x4*)(u + DFF2); v1 = *(const u32x4*)(u + DFF2 + DFF); }
#pragma unroll 4
        for (int r = 0; r < 16; ++r) {
            const bf16_t* u = U + (size_t)(row0 + r) * DFF2 + j0;
            const u32x4 a0 = *(const u32x4*)u, v0 = *(const u32x4*)(u + DFF);
            unsigned ow[4];
#pragma unroll
            for (int q = 0; q < 4; ++q) {
                const float al = ba[2 * q] + wa[0][2 * q] * bflo(a2[q]) + wa[1][2 * q] * bflo(a1[q]) + wa[2][2 * q] * bflo(a0[q]);
                const float ah = ba[2 * q + 1] + wa[0][2 * q + 1] * bfhi(a2[q]) + wa[1][2 * q + 1] * bfhi(a1[q]) + wa[2][2 * q + 1] * bfhi(a0[q]);
                const float vl = bv[2 * q] + wv[0][2 * q] * bflo(v2[q]) + wv[1][2 * q] * bflo(v1[q]) + wv[2][2 * q] * bflo(v0[q]);
                const float vh = bv[2 * q + 1] + wv[0][2 * q + 1] * bfhi(v2[q]) + wv[1][2 * q + 1] * bfhi(v1[q]) + wv[2][2 * q + 1] * bfhi(v0[q]);
                const float gl = al / (1.f + __expf(-al)) * vl, gh = ah / (1.f + __expf(-ah)) * vh;
                ow[q] = pack2(gl, gh);
            }
            *(u32x4*)(G + (size_t)(row0 + r) * DFF + j0) = (u32x4){ow[0], ow[1], ow[2], ow[3]};
            a2 = a1; a1 = a0; v2 = v1; v1 = v0;
        }
    }
}
#define XB_TMO      128
#define XB_XCNT(j)  (256  + 64 * (j))
#define XB_XSUB(j)  (1280 + 64 * (j))
#define XB_XGEN(j)  (2304 + 64 * (j))
#define XB_TOP      3328
#define XB_TOPGEN   3392
#define XCD_BAR_WORDS 3456
#define XB_SPIN_CAP (1u << 18)

__device__ __forceinline__ unsigned xb_ld(unsigned* p)              { return __hip_atomic_load(p, __ATOMIC_RELAXED, __HIP_MEMORY_SCOPE_AGENT); }
__device__ __forceinline__ unsigned xb_add(unsigned* p, unsigned v) { return __hip_atomic_fetch_add(p, v, __ATOMIC_RELAXED, __HIP_MEMORY_SCOPE_AGENT); }
__device__ __forceinline__ unsigned xb_xcc_id() { return (unsigned)__builtin_amdgcn_s_getreg((3 << 11) | 20) & 0xFu; }
#define XB_SPIN(cond, bar) do { unsigned _sp = 0; while (cond) { __builtin_amdgcn_s_sleep(1); \
    if ((++_sp & 255u) == 0u) { if (xb_ld(&(bar)[XB_TMO])) break; if (_sp > XB_SPIN_CAP) { atomicAdd(&(bar)[XB_TMO], 1u); break; } } } } while (0)

struct XcdBarrier {
    unsigned* bar; unsigned x;
    volatile LAS unsigned* st;
};

__device__ __forceinline__ XcdBarrier xcd_barrier_post(unsigned* bar, volatile LAS unsigned* st) {
    XcdBarrier b; b.bar = bar; b.x = xb_xcc_id(); b.st = st;
    if (threadIdx.x == 0) (void)xb_add(&bar[XB_XCNT(b.x)], 1u);
    return b;
}
__device__ __forceinline__ void xcd_barrier_complete(unsigned* bar, unsigned x, unsigned& nloc, unsigned& nx) {
    const unsigned G = gridDim.x * gridDim.y * gridDim.z;
    unsigned sum, cnt, mine, sp = 0u;
    for (;;) {
        sum = 0u; cnt = 0u; mine = 0u;
#pragma unroll
        for (unsigned j = 0; j < 16; ++j) { const unsigned c = xb_ld(&bar[XB_XCNT(j)]); sum += c; cnt += (c > 0u) ? 1u : 0u; mine = (j == x) ? c : mine; }
        if (sum == G) break;
        __builtin_amdgcn_s_sleep(1);
        if ((++sp & 255u) == 0u) { if (xb_ld(&bar[XB_TMO])) break; if (sp > XB_SPIN_CAP) { atomicAdd(&bar[XB_TMO], 1u); break; } }
    }
    nloc = mine > 0u ? mine : 1u; nx = cnt > 0u ? cnt : 1u;
}

__device__ __forceinline__ void xcd_barrier(const XcdBarrier& b) {
    asm volatile("s_waitcnt vmcnt(0)" ::: "memory");
    __syncthreads();
    if (threadIdx.x == 0) {
        unsigned* bar = b.bar;
        __builtin_amdgcn_s_waitcnt(0);
        unsigned nloc = b.st[0], nx = b.st[1];
        if (nloc == 0u) { xcd_barrier_complete(bar, b.x, nloc, nx); b.st[0] = nloc; b.st[1] = nx; }
        const unsigned old = xb_add(&bar[XB_XSUB(b.x)], 1u);
        const unsigned gen = old / nloc;
        if (old + 1u == (gen + 1u) * nloc) {
            __builtin_amdgcn_fence(__ATOMIC_RELEASE, "agent");
            asm volatile("s_waitcnt vmcnt(0)" ::: "memory");
            const unsigned og = xb_add(&bar[XB_TOP], 1u);
            const unsigned tg = og / nx;
            if (og + 1u == (tg + 1u) * nx) xb_add(&bar[XB_TOPGEN], 1u);
            else XB_SPIN(xb_ld(&bar[XB_TOPGEN]) == tg, bar);
            __builtin_amdgcn_fence(__ATOMIC_ACQUIRE, "agent");
            xb_add(&bar[XB_XGEN(b.x)], 1u);
            asm volatile("s_waitcnt vmcnt(0)" ::: "memory");
        } else {
            XB_SPIN(xb_ld(&bar[XB_XGEN(b.x)]) == gen, bar);
            __builtin_amdgcn_fence(__ATOMIC_ACQUIRE, "agent");
            asm volatile("s_waitcnt vmcnt(0)" ::: "memory");
        }
    }
    __syncthreads();
}

constexpr int AT_KSTR = 144, AT_K1 = 64 * AT_KSTR  , AT_VOFF = 2 * AT_K1  , AT_BUF = AT_VOFF + 128 * AT_KSTR  ;
__device__ __forceinline__ void attn_unit(unsigned char* lds, const bf16_t* __restrict__ P, const bf16_t* __restrict__ Vt, bf16_t* __restrict__ OC, const float* subg_lds,
                                          int b, int h, int qt, float lam, float omli) {
    int tid_ = threadIdx.x; asm volatile("" : "+v"(tid_));
    const int tid = tid_, lane = tid & 63, w = __builtin_amdgcn_readfirstlane(tid >> 6), l31 = lane & 31, hi = lane >> 5;
    const int c = w >> 2, qb = w & 3;
    const int nkt = (2 * qt + 2 < 33) ? 2 * qt + 2 : 33;
    const int qrow0 = 128 * qt + 32 * qb;
    const bool active = qrow0 < LP;
    bf16x8 qf[4];
    {
        const bf16_t* qp = P + (size_t)(b * LP + (active ? qrow0 : 0) + l31) * INP + h * 128 + c * 64 + hi * 8;
#pragma unroll
        for (int ks = 0; ks < 4; ++ks) qf[ks] = *(const bf16x8*)(qp + 16 * ks);
    }
    f32x16 O[4];
#pragma unroll
    for (int v = 0; v < 4; ++v)
#pragma unroll
        for (int r = 0; r < 16; ++r) O[v][r] = 0.f;
    float m = -INFINITY, l = 0.f;
    const bf16_t* kbase = P + (size_t)(b * LP) * INP + 1024 + h * 128;
    const bf16_t* vbase = Vt + (size_t)(b * 1024 + h * 128) * LP;
    const int kkey0 = tid >> 4, kch = tid & 15;
    const int vdv0 = tid >> 3, vch = tid & 7;
    const bf16_t* ksrc = kbase + (size_t)kkey0 * INP + kch * 8;
    const bf16_t* vsrc = vbase + (size_t)vdv0 * LP + vch * 8;
    const int kdst = (kch >> 3) * AT_K1 + kkey0 * AT_KSTR + (kch & 7) * 16;
    const int vdst = AT_VOFF + vdv0 * AT_KSTR + vch * 16;
    u32x4 tk0, tk1, tv0, tv1;
#define AT_LOAD(kt) do { const bf16_t* ks_ = ksrc + (size_t)(64 * (kt)) * INP; tk0 = *(const u32x4*)ks_; tk1 = *(const u32x4*)(ks_ + (size_t)32 * INP); \
        const bf16_t* vs_ = vsrc + 64 * (kt); tv0 = *(const u32x4*)vs_; tv1 = *(const u32x4*)(vs_ + (size_t)64 * LP); } while (0)
#define AT_STORE(buf) do { unsigned char* d_ = lds + (buf) * AT_BUF; *(u32x4*)(d_ + kdst) = tk0; *(u32x4*)(d_ + kdst + 32 * AT_KSTR) = tk1; \
        *(u32x4*)(d_ + vdst) = tv0; *(u32x4*)(d_ + vdst + 64 * AT_KSTR) = tv1; } while (0)
    AT_LOAD(0); AT_STORE(0);
    __syncthreads();
    const int krow_off = c * AT_K1 + swap23(l31) * AT_KSTR + hi * 16;
    const int vrow_off = AT_VOFF + l31 * AT_KSTR + hi * 16;
    for (int kt = 0; kt < nkt; ++kt) {
        const bool more = kt + 1 < nkt;
        if (more) AT_LOAD(kt + 1);
        const unsigned char* buf = lds + (kt & 1) * AT_BUF;
        if (active && 64 * kt <= qrow0 + 31) {
            f32x16 s0, s1;
#pragma unroll
            for (int r = 0; r < 16; ++r) { s0[r] = 0.f; s1[r] = 0.f; }
#pragma unroll
            for (int ks = 0; ks < 4; ++ks) {
                const bf16x8 k0 = *(const bf16x8*)(buf + krow_off + ks * 32), k1 = *(const bf16x8*)(buf + krow_off + 32 * AT_KSTR + ks * 32);
                s0 = MFMA32(k0, qf[ks], s0); s1 = MFMA32(k1, qf[ks], s1);
            }
            if (64 * kt + 63 > qrow0) {
                const int q = qrow0 + l31, kb0 = 64 * kt + 8 * hi;
#pragma unroll
                for (int r = 0; r < 16; ++r) { const int key = kb0 + 16 * (r >> 3) + (r & 7); if (key > q) s0[r] = -INFINITY; if (key + 32 > q) s1[r] = -INFINITY; }
            }
            float mx = fmaxf(s0[0], s1[0]);
#pragma unroll
            for (int r = 1; r < 16; ++r) mx = fmaxf(mx, fmaxf(s0[r], s1[r]));
            mx = fmaxf(mx, __shfl_xor(mx, 32));
            const float mn = fmaxf(m, mx), alpha = __builtin_amdgcn_exp2f(m - mn);
            m = mn;
            float sum = 0.f;
#pragma unroll
            for (int r = 0; r < 16; ++r) { s0[r] = __builtin_amdgcn_exp2f(s0[r] - mn); s1[r] = __builtin_amdgcn_exp2f(s1[r] - mn); sum += s0[r] + s1[r]; }
            l = l * alpha + sum;
#pragma unroll
            for (int v = 0; v < 4; ++v)
#pragma unroll
                for (int r = 0; r < 16; ++r) O[v][r] *= alpha;
            const bf16x8 p00 = pack8(s0, 0), p01 = pack8(s0, 1), p10 = pack8(s1, 0), p11 = pack8(s1, 1);
#pragma unroll
            for (int v = 0; v < 4; ++v) {
                const unsigned char* vp = buf + vrow_off + v * 32 * AT_KSTR;
                const bf16x8 a0 = *(const bf16x8*)(vp), a1 = *(const bf16x8*)(vp + 32), a2 = *(const bf16x8*)(vp + 64), a3 = *(const bf16x8*)(vp + 96);
                O[v] = MFMA32(a0, p00, O[v]); O[v] = MFMA32(a1, p01, O[v]); O[v] = MFMA32(a2, p10, O[v]); O[v] = MFMA32(a3, p11, O[v]);
            }
        }
        if (more) AT_STORE((kt + 1) & 1);
        __syncthreads();
    }
#undef AT_LOAD
#undef AT_STORE
    l += __shfl_xor(l, 32);
    const float inv = 1.f / l;
    float* ex = (float*)lds + (size_t)qb * 4096;
    if (c == 1 && active) {
#pragma unroll
        for (int v = 0; v < 4; ++v)
#pragma unroll
            for (int r = 0; r < 16; ++r) ex[(v * 16 + r) * 64 + lane] = O[v][r] * inv;
    }
    __syncthreads();
    if (c == 0 && active) {
        float ss = 0.f;
#pragma unroll
        for (int v = 0; v < 4; ++v)
#pragma unroll
            for (int r = 0; r < 16; ++r) { const float o = O[v][r] * inv - lam * ex[(v * 16 + r) * 64 + lane]; O[v][r] = o; ss += o * o; }
        ss += __shfl_xor(ss, 32);
        const float rs = rsqrtf(ss * (1.f / 128.f) + EPS) * omli;
        bf16_t* orow = OC + (size_t)(b * LP + qrow0 + l31) * DM + h * 128;
#pragma unroll
        for (int v = 0; v < 4; ++v)
#pragma unroll
            for (int r4 = 0; r4 < 4; ++r4) { const int dv = 32 * v + 8 * r4 + 4 * hi; const f32x4 g = *(const f32x4*)(subg_lds + dv);
                u32x2 wv; wv.x = pack2(O[v][4 * r4] * rs * g.x, O[v][4 * r4 + 1] * rs * g.y); wv.y = pack2(O[v][4 * r4 + 2] * rs * g.z, O[v][4 * r4 + 3] * rs * g.w);
                *(u32x2*)(orow + dv) = wv; }
    }
    __syncthreads();
}

constexpr int GL_QSTR = 272, GL_TSTR = 144;
constexpr int GL_QIN = 0, GL_KIN = 64 * GL_QSTR  , GL_KOUT = 2 * 64 * GL_QSTR  , GL_VT = GL_KOUT + 128 * GL_TSTR  , GL_LR = GL_VT + 256 * GL_TSTR  ,
              GL_SEG = GL_LR + 4096, GL_DEC = GL_SEG + 2048, GL_NG = GL_DEC + 512, GL_RAWQ = GL_NG + 1024  , GL_RAWK = GL_RAWQ + 16384, GL_END = GL_RAWK + 16384  ;
constexpr int GL_OSTR = 260;
constexpr int NCHUNK = LP / 64, NGU = 16 * NCHUNK;

#define GL_GATE() \
        float bc[16]; float run = 0.f; \
        _Pragma("unroll") for (int i = 0; i < 16; ++i) { \
            const float* lr = LR + (16 * seg + i) * 16; float z = b2r; \
            _Pragma("unroll") for (int j = 0; j < 16; j += 4) { const f32x4 v = *(const f32x4*)(lr + j); z += v.x * w2r[j] + v.y * w2r[j + 1] + v.z * w2r[j + 2] + v.w * w2r[j + 3]; } \
            const float ls = fminf(z, 0.f) - __logf(1.f + __expf(-fabsf(z))); \
            run += ls * (1.f / 16.f); bc[i] = run; } \
        SEG[seg * 128 + d] = run; \
        __syncthreads(); \
        float off = 0.f, tot = 0.f; \
        _Pragma("unroll") for (int s = 0; s < 4; ++s) { const float v = SEG[s * 128 + d]; tot += v; if (s < seg) off += v; }

__device__ __forceinline__ void gla_m1(unsigned char* lds, const bf16_t* __restrict__ P, const bf16_t* __restrict__ Vt, float* __restrict__ KV, float* __restrict__ DECb,
                                       const float* __restrict__ w2, const float* __restrict__ b2, int u) {
    int tid_ = threadIdx.x; asm volatile("" : "+v"(tid_));
    const int tid = tid_, lane = tid & 63, w = __builtin_amdgcn_readfirstlane(tid >> 6), l31 = lane & 31, hi = lane >> 5;
    const int bh = u / NCHUNK, n = u - bh * NCHUNK, b = bh >> 2, h = bh & 3;
    const int d = tid & 127, seg = tid >> 7;
    float w2r[16];
#pragma unroll
    for (int j = 0; j < 16; ++j) w2r[j] = w2[(size_t)j * 512 + h * 128 + d];
    const float b2r = b2[h * 128 + d];
    float* LR = (float*)(lds + GL_LR); float* SEG = (float*)(lds + GL_SEG);
    const int tok8 = tid >> 3, part = tid & 7;
    const size_t R0 = (size_t)b * LP + 64 * n;
    const unsigned lrw = *(const unsigned*)(P + (R0 + tok8) * INP + 6144 + 2 * part);
    { const bf16_t* kp = P + (R0 + (tid >> 4)) * INP + 3584 + h * 128 + (tid & 15) * 8;
      const u32x4 k0 = *(const u32x4*)kp, k1 = *(const u32x4*)(kp + (size_t)32 * INP);
      unsigned char* rk = lds + GL_RAWK + (tid >> 4) * 256 + (tid & 15) * 16;
      *(u32x4*)rk = k0; *(u32x4*)(rk + 32 * 256) = k1; }
    u32x4 vt[4];
    { const bf16_t* vp = Vt + ((size_t)b * 1024 + h * 256 + (tid >> 3)) * LP + 64 * n + (tid & 7) * 8;
#pragma unroll
      for (int i = 0; i < 4; ++i) vt[i] = *(const u32x4*)(vp + (size_t)(64 * i) * LP); }
    LR[tok8 * 16 + 2 * part] = bflo(lrw); LR[tok8 * 16 + 2 * part + 1] = bfhi(lrw);
    __syncthreads();
    GL_GATE()
    if (seg == 0) DECb[(size_t)u * 128 + d] = __expf(tot);
    {
        unsigned ko[8];
#pragma unroll
        for (int i = 0; i < 16; i += 2) {
            const float b0 = bc[i] + off, b1 = bc[i + 1] + off;
            const bf16_t* rk = (const bf16_t*)(lds + GL_RAWK + (16 * seg + i) * 256) + d;
            ko[i >> 1] = pack2(bf2f(rk[0]) * __expf(tot - b0), bf2f(rk[128]) * __expf(tot - b1));
        }
        unsigned char* kod = lds + GL_KOUT + d * GL_TSTR + seg * 32;
        *(u32x4*)kod = (u32x4){ko[0], ko[1], ko[2], ko[3]}; *(u32x4*)(kod + 16) = (u32x4){ko[4], ko[5], ko[6], ko[7]};
#pragma unroll
        for (int i = 0; i < 4; ++i) *(u32x4*)(lds + GL_VT + ((tid >> 3) + 64 * i) * GL_TSTR + (tid & 7) * 16) = vt[i];
    }
    __syncthreads();
    const unsigned char* va = lds + GL_VT + (32 * w + l31) * GL_TSTR + hi * 16;
    const bf16x8 v0 = *(const bf16x8*)(va), v1 = *(const bf16x8*)(va + 32), v2 = *(const bf16x8*)(va + 64), v3 = *(const bf16x8*)(va + 96);
    float* kvo = KV + (size_t)u * 32768 + (size_t)(w * 4) * 1024 + lane;
#pragma unroll
    for (int kb = 0; kb < 4; ++kb) {
        f32x16 S;
#pragma unroll
        for (int r = 0; r < 16; ++r) S[r] = 0.f;
        const unsigned char* ko = lds + GL_KOUT + (32 * kb + l31) * GL_TSTR + hi * 16;
        S = MFMA32(*(const bf16x8*)(ko), v0, S); S = MFMA32(*(const bf16x8*)(ko + 32), v1, S);
        S = MFMA32(*(const bf16x8*)(ko + 64), v2, S); S = MFMA32(*(const bf16x8*)(ko + 96), v3, S);
#pragma unroll
        for (int r = 0; r < 16; ++r) kvo[(kb * 16 + r) * 64] = S[r];
    }
}

__device__ __forceinline__ void gla_scan(const float* __restrict__ KV, const float* __restrict__ DECb, u32x4* __restrict__ SP, int g) {
    const int lane = g & 63, s = (g >> 6) & 1, kb = (g >> 7) & 3, w = (g >> 9) & 7, bh = g >> 12, hi = lane >> 5;
    const float* kv = KV + (size_t)(bh * NCHUNK) * 32768 + (size_t)((w * 4 + kb) * 16 + 8 * s) * 64 + lane;
    const float* dc = DECb + (size_t)(bh * NCHUNK) * 128 + 32 * kb + 16 * s + 4 * hi;
    u32x4* sp = SP + (size_t)(bh * NCHUNK) * 4096 + ((w * 4 + kb) * 2 + s) * 64 + lane;
    float S[8];
#pragma unroll
    for (int j = 0; j < 8; ++j) S[j] = 0.f;
#pragma unroll 3
    for (int n = 0; n < NCHUNK; ++n) {
        float t[8];
#pragma unroll
        for (int j = 0; j < 8; ++j) t[j] = kv[(size_t)n * 32768 + j * 64];
        const f32x4 d0 = *(const f32x4*)(dc + (size_t)n * 128), d1 = *(const f32x4*)(dc + (size_t)n * 128 + 8);
        sp[(size_t)n * 4096] = (u32x4){pack2(S[0], S[1]), pack2(S[2], S[3]), pack2(S[4], S[5]), pack2(S[6], S[7])};
        S[0] = S[0] * d0.x + t[0]; S[1] = S[1] * d0.y + t[1]; S[2] = S[2] * d0.z + t[2]; S[3] = S[3] * d0.w + t[3];
        S[4] = S[4] * d1.x + t[4]; S[5] = S[5] * d1.y + t[5]; S[6] = S[6] * d1.z + t[6]; S[7] = S[7] * d1.w + t[7];
    }
}

__device__ __forceinline__ void gla_m3(unsigned char* lds, const bf16_t* __restrict__ P, const bf16_t* __restrict__ Vt, const u32x4* __restrict__ SP, bf16_t* __restrict__ OC,
                                       const float* __restrict__ w2, const float* __restrict__ b2, const float* __restrict__ ng, int u) {
    int tid_ = threadIdx.x; asm volatile("" : "+v"(tid_));
    const int tid = tid_, lane = tid & 63, w = __builtin_amdgcn_readfirstlane(tid >> 6), l31 = lane & 31, hi = lane >> 5;
    const int bh = u / NCHUNK, n = u - bh * NCHUNK, b = bh >> 2, h = bh & 3;
    const int d = tid & 127, seg = tid >> 7;
    float w2r[16];
#pragma unroll
    for (int j = 0; j < 16; ++j) w2r[j] = w2[(size_t)j * 512 + h * 128 + d];
    const float b2r = b2[h * 128 + d];
    float* LR = (float*)(lds + GL_LR); float* SEG = (float*)(lds + GL_SEG); float* NG = (float*)(lds + GL_NG);
    if (tid < 256) NG[tid] = ng[tid];
    const int dpos = swap23(d);
    const int tok8 = tid >> 3, part = tid & 7;
    const size_t R0 = (size_t)b * LP + 64 * n;
    const unsigned lrw = *(const unsigned*)(P + (R0 + tok8) * INP + 6144 + 2 * part);
    { const bf16_t* qp = P + (R0 + (tid >> 4)) * INP + 3072 + h * 128 + (tid & 15) * 8;
      const u32x4 q0 = *(const u32x4*)qp, q1 = *(const u32x4*)(qp + (size_t)32 * INP), k0 = *(const u32x4*)(qp + 512), k1 = *(const u32x4*)(qp + (size_t)32 * INP + 512);
      unsigned char* rq = lds + GL_RAWQ + (tid >> 4) * 256 + (tid & 15) * 16;
      *(u32x4*)rq = q0; *(u32x4*)(rq + 32 * 256) = q1; *(u32x4*)(rq + 16384) = k0; *(u32x4*)(rq + 16384 + 32 * 256) = k1; }
    u32x4 vt[4];
    { const bf16_t* vp = Vt + ((size_t)b * 1024 + h * 256 + (tid >> 3)) * LP + 64 * n + (tid & 7) * 8;
#pragma unroll
      for (int i = 0; i < 4; ++i) vt[i] = *(const u32x4*)(vp + (size_t)(64 * i) * LP); }
    LR[tok8 * 16 + 2 * part] = bflo(lrw); LR[tok8 * 16 + 2 * part + 1] = bfhi(lrw);
    __syncthreads();
    GL_GATE()
    {
#pragma unroll
        for (int i = 0; i < 16; i += 2) {
            const float b0 = bc[i] + off, b1 = bc[i + 1] + off;
            const bf16_t* rq = (const bf16_t*)(lds + GL_RAWQ + (16 * seg + i) * 256) + d;
            const float q0 = bf2f(rq[0]) * __expf(b0) * 0.08838834764831845f, q1 = bf2f(rq[128]) * __expf(b1) * 0.08838834764831845f;
            const float k0 = bf2f(rq[8192]), k1 = bf2f(rq[8192 + 128]);
            const unsigned qq = pack2(q0, q1), kk = pack2(k0 * __expf(-b0), k1 * __expf(-b1));
            bf16_t* qd = (bf16_t*)(lds + GL_QIN + (16 * seg + i) * GL_QSTR) + dpos; bf16_t* kd = (bf16_t*)(lds + GL_KIN + (16 * seg + i) * GL_QSTR) + dpos;
            qd[0] = (bf16_t)(qq & 0xffffu); qd[GL_QSTR / 2] = (bf16_t)(qq >> 16); kd[0] = (bf16_t)(kk & 0xffffu); kd[GL_QSTR / 2] = (bf16_t)(kk >> 16);
        }
#pragma unroll
        for (int i = 0; i < 4; ++i) *(u32x4*)(lds + GL_VT + ((tid >> 3) + 64 * i) * GL_TSTR + (tid & 7) * 16) = vt[i];
    }
    u32x4 sp[8];
    { const u32x4* spp = SP + (size_t)u * 4096 + (size_t)(w * 8) * 64 + lane;
#pragma unroll
      for (int i = 0; i < 8; ++i) sp[i] = spp[i * 64]; }
    __syncthreads();
    f32x16 X00, X01, X11;
#pragma unroll
    for (int r = 0; r < 16; ++r) { X00[r] = 0.f; X01[r] = 0.f; X11[r] = 0.f; }
    {
        const unsigned char* ka = lds + GL_KIN + swap23(l31) * GL_QSTR + hi * 16;
        const unsigned char* qa = lds + GL_QIN + l31 * GL_QSTR + hi * 16;
#pragma unroll 2
        for (int ks = 0; ks < 8; ++ks) {
            const bf16x8 k0 = *(const bf16x8*)(ka + ks * 32), k1 = *(const bf16x8*)(ka + 32 * GL_QSTR + ks * 32);
            const bf16x8 q0 = *(const bf16x8*)(qa + ks * 32), q1 = *(const bf16x8*)(qa + 32 * GL_QSTR + ks * 32);
            X00 = MFMA32(k0, q0, X00); X01 = MFMA32(k0, q1, X01); X11 = MFMA32(k1, q1, X11);
        }
#pragma unroll
        for (int r = 0; r < 16; ++r) { const int j = 16 * (r >> 3) + 8 * hi + (r & 7); if (j > l31) { X00[r] = 0.f; X11[r] = 0.f; } }
    }
    f32x16 Oa, Ob; u32x4 go[4];
#pragma unroll
    for (int r = 0; r < 16; ++r) { Oa[r] = 0.f; Ob[r] = 0.f; }
    {
        const unsigned char* va = lds + GL_VT + (32 * w + l31) * GL_TSTR + hi * 16;
        const bf16x8 v0 = *(const bf16x8*)(va), v1 = *(const bf16x8*)(va + 32), v2 = *(const bf16x8*)(va + 64), v3 = *(const bf16x8*)(va + 96);
        Oa = MFMA32(pack8(X00, 0), v0, Oa); Oa = MFMA32(pack8(X00, 1), v1, Oa);
        Ob = MFMA32(pack8(X01, 0), v0, Ob); Ob = MFMA32(pack8(X01, 1), v1, Ob);
        Ob = MFMA32(pack8(X11, 0), v2, Ob); Ob = MFMA32(pack8(X11, 1), v3, Ob);
        { const bf16_t* gp = P + (R0 + tok8) * INP + 5120 + h * 256 + 32 * part;
#pragma unroll
          for (int i = 0; i < 4; ++i) go[i] = *(const u32x4*)(gp + 8 * i); }
        const unsigned char* qa = lds + GL_QIN + l31 * GL_QSTR + hi * 16;
#pragma unroll
        for (int kb = 0; kb < 4; ++kb)
#pragma unroll
            for (int s = 0; s < 2; ++s) {
                const bf16x8 sb = __builtin_bit_cast(bf16x8, sp[kb * 2 + s]);
                const bf16x8 q0 = *(const bf16x8*)(qa + kb * 64 + s * 32), q1 = *(const bf16x8*)(qa + 32 * GL_QSTR + kb * 64 + s * 32);
                Oa = MFMA32(q0, sb, Oa); Ob = MFMA32(q1, sb, Ob);
            }
    }
    __syncthreads();
    {
        float* ost = (float*)lds;
#pragma unroll
        for (int r = 0; r < 16; ++r) { ost[crow(r, hi) * GL_OSTR + 32 * w + l31] = Oa[r]; ost[(32 + crow(r, hi)) * GL_OSTR + 32 * w + l31] = Ob[r]; }
    }
    __syncthreads();
    {
        const float* orow = (const float*)lds + tok8 * GL_OSTR + 32 * part;
        f32x4 ov[8]; float ss = 0.f;
#pragma unroll
        for (int i = 0; i < 8; ++i) { ov[i] = *(const f32x4*)(orow + 4 * i); ss += (ov[i].x * ov[i].x + ov[i].y * ov[i].y) + (ov[i].z * ov[i].z + ov[i].w * ov[i].w); }
        ss += __shfl_xor(ss, 1); ss += __shfl_xor(ss, 2); ss += __shfl_xor(ss, 4);
        const float rs = rsqrtf(ss * (1.f / 256.f) + EPS);
        bf16_t* od = OC + (R0 + tok8) * DM + 1024 + h * 256 + 32 * part;
#pragma unroll
        for (int i = 0; i < 4; ++i) {
            unsigned ow[4];
#pragma unroll
            for (int q = 0; q < 4; ++q) {
                const int e = 8 * i + 2 * q; const f32x4 o4 = ov[e >> 2]; const float o0 = (e & 2) ? o4.z : o4.x, o1 = (e & 2) ? o4.w : o4.y;
                const float g0 = bflo(go[i][q]), g1 = bfhi(go[i][q]);
                ow[q] = pack2(o0 * rs * NG[32 * part + e] * (g0 / (1.f + __expf(-g0))), o1 * rs * NG[32 * part + e + 1] * (g1 / (1.f + __expf(-g1))));
            }
            *(u32x4*)(od + 8 * i) = (u32x4){ow[0], ow[1], ow[2], ow[3]};
        }
    }
}

constexpr int PTAB = 131072;
#ifndef RP_PRO
#define RP_PRO 1
#endif
#ifndef RP_MIX
#define RP_MIX 1
#endif
#ifndef RP_G3
#define RP_G3 1
#endif
#ifndef RP_G4
#define RP_G4 1
#endif
#ifndef RP_GLA
#define RP_GLA 1
#endif
#ifndef RP_ATT
#define RP_ATT 1
#endif
#ifndef RP_CONV
#define RP_CONV 1
#endif
enum { T_X = 0, T_META, T_PRE_MIX_G, T_W_IN, T_DA_LAMBDA, T_DA_SUBLN_G, T_GATE_W2, T_GATE_B, T_GLA_NORM_G, T_W_OUT, T_POST_MIX_G, T_PRE_FFN_G, T_W_UP, T_CONV_W, T_CONV_B, T_W_DOWN, T_POST_FFN_G, T_OUT, T_WS, T_N };
__device__ __forceinline__ unsigned long long ldp_(const unsigned char* lds, int i) {
    const unsigned long long v = ((const volatile unsigned long long*)(lds + PTAB))[i];
    const unsigned lo = __builtin_amdgcn_readfirstlane((unsigned)v), hi = __builtin_amdgcn_readfirstlane((unsigned)(v >> 32));
    return ((unsigned long long)hi << 32) | lo;
}
#define LDF(i) ((const float*)ldp_(lds, (i)))
#define LDWS() ((unsigned char*)ldp_(lds, T_WS))
__global__ void __launch_bounds__(NTHR) hymba_fwd(Params p) {
    extern __shared__ __attribute__((aligned(16))) unsigned char lds[];
    cg::grid_group grid = cg::this_grid();
    if (threadIdx.x == 0) {
        unsigned long long* tab = (unsigned long long*)(lds + PTAB);
        tab[T_X] = (unsigned long long)p.x; tab[T_META] = (unsigned long long)p.meta; tab[T_PRE_MIX_G] = (unsigned long long)p.pre_mix_g; tab[T_W_IN] = (unsigned long long)p.w_in;
        tab[T_DA_LAMBDA] = (unsigned long long)p.da_lambda; tab[T_DA_SUBLN_G] = (unsigned long long)p.da_subln_g; tab[T_GATE_W2] = (unsigned long long)p.gate_w2; tab[T_GATE_B] = (unsigned long long)p.gate_b;
        tab[T_GLA_NORM_G] = (unsigned long long)p.gla_norm_g; tab[T_W_OUT] = (unsigned long long)p.w_out; tab[T_POST_MIX_G] = (unsigned long long)p.post_mix_g; tab[T_PRE_FFN_G] = (unsigned long long)p.pre_ffn_g;
        tab[T_W_UP] = (unsigned long long)p.w_up; tab[T_CONV_W] = (unsigned long long)p.conv_w; tab[T_CONV_B] = (unsigned long long)p.conv_b; tab[T_W_DOWN] = (unsigned long long)p.w_down;
        tab[T_POST_FFN_G] = (unsigned long long)p.post_ffn_g; tab[T_OUT] = (unsigned long long)p.out; tab[T_WS] = (unsigned long long)p.ws;
    }
    if (threadIdx.x == 0) { volatile LAS unsigned* st = (volatile LAS unsigned*)((LAS unsigned char*)lds + PTAB + 256); st[0] = 0u; st[1] = 0u; }
    __syncthreads();
    if ((p.ph_hi - p.ph_lo) > 1) (void)xcd_barrier_post((unsigned*)(p.ws + WS_CTL), (volatile LAS unsigned*)((LAS unsigned char*)lds + PTAB + 256));
    const int lo = p.ph_lo, hi_ = p.ph_hi; const bool multi = (hi_ - lo) > 1;
    int ph = 0;
#define IN_PH() (ph >= lo && ph < hi_)
#define SEAM() do { ++ph; if (multi) { if (ph == 1) grid.sync(); else { XcdBarrier xb_; xb_.bar = (unsigned*)(LDWS() + WS_CTL); xb_.x = xb_xcc_id(); xb_.st = (volatile LAS unsigned*)((LAS unsigned char*)lds + PTAB + 256); xcd_barrier(xb_); } } } while (0)
#define PH_VARS() int tid_ = threadIdx.x; asm volatile("" : "+v"(tid_)); int bx = blockIdx.x; asm volatile("" : "+s"(bx)); const int G = gridDim.x; \
    const int tid = tid_, lane = tid & 63, wave = __builtin_amdgcn_readfirstlane(tid >> 6); const int gw = bx * NWAVE + wave, ngw = G * NWAVE; \
    unsigned char* ws = LDWS(); LAS unsigned char* ldsa = (LAS unsigned char*)lds; (void)lane; (void)gw; (void)ngw; (void)ldsa; (void)ws

#ifndef NO_PRO
    for (int rp = 0; rp < RP_PRO; ++rp) if (IN_PH()) {
        PH_VARS();
        LAS float* scr = (LAS float*)(ldsa + wave * 16384);
        constexpr int NB_IN = INP / 32, NB_D = DM / 32, NB_UP = DFF2 / 32;
        constexpr int I_IN = (DM / 64) * NB_IN, I_OUT = (DM / 64) * NB_D, I_UP = (DM / 64) * NB_UP, I_DN = (DFF / 64) * NB_D, I_L = I_IN + I_OUT + I_UP + I_DN;
        const float* w_in = LDF(T_W_IN); const float* w_out = LDF(T_W_OUT); const float* w_up = LDF(T_W_UP); const float* w_dn = LDF(T_W_DOWN);
#define TDEC(ti, it_) do { const int l_ = (it_) / I_L; int r_ = (it_) - l_ * I_L; int nblk_; \
            if (r_ < I_IN) { ti.W = w_in + (size_t)l_ * DM * INC; ti.WT = (bf16_t*)(ws + WS_WIN) + (size_t)l_ * INP * DM; ti.K = DM; ti.Nsrc = INC; nblk_ = NB_IN; } \
            else if ((r_ -= I_IN) < I_OUT) { ti.W = w_out + (size_t)l_ * DM * DM; ti.WT = (bf16_t*)(ws + WS_WOUT) + (size_t)l_ * DM * DM; ti.K = DM; ti.Nsrc = DM; nblk_ = NB_D; } \
            else if ((r_ -= I_OUT) < I_UP) { ti.W = w_up + (size_t)l_ * DM * DFF2; ti.WT = (bf16_t*)(ws + WS_WUP) + (size_t)l_ * DFF2 * DM; ti.K = DM; ti.Nsrc = DFF2; nblk_ = NB_UP; } \
            else { r_ -= I_UP; ti.W = w_dn + (size_t)l_ * DFF * DM; ti.WT = (bf16_t*)(ws + WS_WDN) + (size_t)l_ * DM * DFF; ti.K = DFF; ti.Nsrc = DM; nblk_ = NB_D; } \
            const int kb_ = r_ / nblk_; ti.k0 = 64 * kb_; ti.n0 = 32 * (r_ - kb_ * nblk_); } while (0)
        {
            constexpr int NIT = DEPTH * I_L;
            float ra[32], rb[32]; TItem ta, tb;
            int it = gw;
            if (it < NIT) {
                TDEC(ta, it); titem_load(ta, ra, lane);
                for (;;) {
                    const int itb = it + ngw; const bool vb = itb < NIT;
                    if (vb) { TDEC(tb, itb); titem_load(tb, rb, lane); }
                    titem_store(ta, ra, scr, lane);
                    if (!vb) break;
                    it = itb + ngw; const bool va = it < NIT;
                    if (va) { TDEC(ta, it); titem_load(ta, ra, lane); }
                    titem_store(tb, rb, scr, lane);
                    if (!va) break;
                }
            }
        }
#undef TDEC
        row_phase<0>(LDF(T_X), LDF(T_META), nullptr, (float*)(ws + WS_X), nullptr, nullptr, 0, (bf16_t*)(ws + WS_H), nullptr, LDF(T_PRE_MIX_G), gw, ngw, lane);
    }
#endif
    SEAM();

    for (int l = 0; l < DEPTH; ++l) {
        if (IN_PH()) {
            PH_VARS();
            pg8::Gemm g{(bf16_t*)(ws + WS_H), (bf16_t*)(ws + WS_WIN) + (size_t)l * INP * DM, MP, INP, DM}; pg8::StaticOrder S; S.init(MP, INP, G, bx);
            pg8::EpiIn E{(bf16_t*)(ws + WS_P), INP, (bf16_t*)(ws + WS_VTA), (bf16_t*)(ws + WS_VTB), LP, 0.125f * 1.4426950408889634f};
#ifndef NO_G1
            pg8::gemm_phase<pg8::EpiIn, pg8::StaticOrder, true, true>(ldsa, g, S, E);
#endif
        }
        SEAM();
        for (int sub = 0; sub < 3; ++sub) {
            for (int rp = 0; rp < RP_MIX; ++rp) if (IN_PH()) {
                PH_VARS();
                const bf16_t* P = (const bf16_t*)(ws + WS_P); bf16_t* OC = (bf16_t*)(ws + WS_OC);
                if (sub == 1) {
                    if (tid < 256 && bx * 256 + tid < 65536) gla_scan((const float*)(ws + WS_KV), (const float*)(ws + WS_DEC), (u32x4*)(ws + WS_SP), bx * 256 + tid);
                } else {
                    if (sub == 0) { for (int u = G - 1 - bx; u < NGU; u += G) gla_m1(lds, P, (const bf16_t*)(ws + WS_VTB), (float*)(ws + WS_KV), (float*)(ws + WS_DEC), LDF(T_GATE_W2) + (size_t)l * 16 * 512, LDF(T_GATE_B) + (size_t)l * 512, u); }
                    else { for (int u = bx; u < NGU; u += G) gla_m3(lds, P, (const bf16_t*)(ws + WS_VTB), (const u32x4*)(ws + WS_SP), OC, LDF(T_GATE_W2) + (size_t)l * 16 * 512, LDF(T_GATE_B) + (size_t)l * 512, LDF(T_GLA_NORM_G) + (size_t)l * 256, u); }
                    __syncthreads();
                    float* subg = (float*)(lds + 80000); float* lamw = subg + 128;
                    const float lam_init = 0.8f - 0.6f * __expf(-0.3f * (float)l);
                    if (tid < 128) subg[tid] = LDF(T_DA_SUBLN_G)[(size_t)l * 128 + tid];
                    if (wave == 0) { const float* lv = LDF(T_DA_LAMBDA) + (size_t)l * 256; const float a = wave_sum(lv[lane] * lv[64 + lane]), c2 = wave_sum(lv[128 + lane] * lv[192 + lane]);
                        if (lane == 0) lamw[0] = __expf(a) - __expf(c2) + lam_init; }
                    __syncthreads();
                    const float lam = lamw[0];
                    for (int ra = 0; ra < RP_ATT; ++ra) for (int k = (sub == 0 ? 0 : 1); k * G < 544 && (sub != 0 || k < 1); ++k) {
                        const int j = k * G + ((k & 1) ? (G - 1 - bx) : bx);
                        if (j < 544) attn_unit(lds, P, (const bf16_t*)(ws + WS_VTA), OC, subg, (j & 31) >> 3, j & 7, 16 - (j >> 5), lam, 1.f - lam_init);
                    }
                }
            }
            SEAM();
        }
        if (IN_PH()) {
            PH_VARS();
            { pg8::Gemm g{(bf16_t*)(ws + WS_OC), (bf16_t*)(ws + WS_WOUT) + (size_t)l * DM * DM, MP, DM, DM, DM}; pg8::FullOrder32 S{G, bx};
              pg8::EpiF32 E{(float*)(ws + WS_Y), DM};
              pg8::gemm_phase<pg8::EpiF32, pg8::FullOrder32, true, true>(ldsa, g, S, E); }
            __builtin_amdgcn_sched_barrier(0); asm volatile("" : "+s"(bx) :: "memory"); __builtin_amdgcn_sched_barrier(0);
            { int kp = 256; asm volatile("" : "+s"(kp)); pg8::Gemm g{(bf16_t*)(ws + WS_OC), (bf16_t*)(ws + WS_WOUT) + (size_t)l * DM * DM, MP, DM, kp, DM}; pg8::SplitOrder32 S{G, bx, 8, kp};
              pg8::EpiPart E{(float*)(ws + WS_PART), DM, kp};
              pg8::gemm_phase<pg8::EpiPart, pg8::SplitOrder32, true, true>(ldsa, g, S, E); }
        }
        SEAM();
#ifndef NO_ROW
        if (IN_PH()) { PH_VARS(); row_phase<1>(nullptr, nullptr, nullptr, (float*)(ws + WS_X), (const float*)(ws + WS_Y), (const float*)(ws + WS_PART), 8, (bf16_t*)(ws + WS_H), LDF(T_POST_MIX_G) + (size_t)l * DM, LDF(T_PRE_FFN_G) + (size_t)l * DM, gw, ngw, lane); }
#endif
        SEAM();
        for (int rp = 0; rp < RP_G3; ++rp) if (IN_PH()) {
            PH_VARS();
            pg8::Gemm g{(bf16_t*)(ws + WS_H), (bf16_t*)(ws + WS_WUP) + (size_t)l * DFF2 * DM, MP, DFF2, DM}; pg8::StaticOrder S; S.init(MP, DFF2, G, bx);
            pg8::EpiB16 E{(bf16_t*)(ws + WS_U), DFF2};
#ifndef NO_G3
            pg8::gemm_phase<pg8::EpiB16, pg8::StaticOrder, true, true>(ldsa, g, S, E);
#endif
        }
        SEAM();
#ifndef NO_CONV
        for (int rp = 0; rp < RP_CONV; ++rp) if (IN_PH()) { PH_VARS(); conv_phase((const bf16_t*)(ws + WS_U), (bf16_t*)(ws + WS_G), LDF(T_CONV_W) + (size_t)l * 3 * DFF2, LDF(T_CONV_B) + (size_t)l * DFF2, bx * NTHR + tid, G * NTHR); }
#endif
        SEAM();
        for (int rp = 0; rp < RP_G4; ++rp) if (IN_PH()) {
            PH_VARS();
            { pg8::Gemm g{(bf16_t*)(ws + WS_G), (bf16_t*)(ws + WS_WDN) + (size_t)l * DM * DFF, MP, DM, DFF, DFF}; pg8::FullOrder32 S{G, bx};
              pg8::EpiF32 E{(float*)(ws + WS_Y), DM};
              pg8::gemm_phase<pg8::EpiF32, pg8::FullOrder32, true, true>(ldsa, g, S, E); }
            __builtin_amdgcn_sched_barrier(0); asm volatile("" : "+s"(bx) :: "memory"); __builtin_amdgcn_sched_barrier(0);
            { int kp = 256; asm volatile("" : "+s"(kp)); pg8::Gemm g{(bf16_t*)(ws + WS_G), (bf16_t*)(ws + WS_WDN) + (size_t)l * DM * DFF, MP, DM, kp, DFF}; pg8::SplitOrder32 S{G, bx, 22, kp};
              pg8::EpiPart E{(float*)(ws + WS_PART), DM, kp};
              pg8::gemm_phase<pg8::EpiPart, pg8::SplitOrder32, true, true>(ldsa, g, S, E); }
        }
        SEAM();
#ifndef NO_ROW
        if (IN_PH()) {
            PH_VARS();
            if (l + 1 < DEPTH) row_phase<1>(nullptr, nullptr, nullptr, (float*)(ws + WS_X), (const float*)(ws + WS_Y), (const float*)(ws + WS_PART), 22, (bf16_t*)(ws + WS_H), LDF(T_POST_FFN_G) + (size_t)l * DM, LDF(T_PRE_MIX_G) + (size_t)(l + 1) * DM, gw, ngw, lane);
            else row_phase<2>(nullptr, nullptr, (float*)ldp_(lds, T_OUT), (float*)(ws + WS_X), (const float*)(ws + WS_Y), (const float*)(ws + WS_PART), 22, nullptr, LDF(T_POST_FFN_G) + (size_t)l * DM, nullptr, gw, ngw, lane);
        }
#endif
        if (l + 1 < DEPTH) SEAM(); else ++ph;
    }
#undef IN_PH
#undef SEAM
}
constexpr int N_PHASES = 1 + 10 * DEPTH;

#ifndef MULTI_LAUNCH
#define MULTI_LAUNCH 0
#endif
extern "C" void kernel_launch(void* const* d_in, const int* in_sizes, int n_in, void* d_out, int out_size, void* d_ws, size_t ws_size, hipStream_t stream) {
    static int grid = 0;
    if (grid == 0) {
        if (n_in != 17 || ws_size < WS_END) { fprintf(stderr, "kernel_launch: need 17 inputs and %zu bytes of workspace (got %d, %zu)\n", (size_t)WS_END, n_in, ws_size); grid = -1; return; }
        int dev = 0, cus = 0, per_cu = 0;
        hipGetDevice(&dev); hipDeviceGetAttribute(&cus, hipDeviceAttributeMultiprocessorCount, dev);
        if (hipFuncSetAttribute((const void*)hymba_fwd, hipFuncAttributeMaxDynamicSharedMemorySize, LDS_BYTES) != hipSuccess) { fprintf(stderr, "kernel_launch: hipFuncSetAttribute failed\n"); grid = -1; return; }
        if (hipOccupancyMaxActiveBlocksPerMultiprocessor(&per_cu, (const void*)hymba_fwd, NTHR, LDS_BYTES) != hipSuccess || per_cu < 1) { fprintf(stderr, "kernel_launch: occupancy query gave %d\n", per_cu); per_cu = 1; }
        (void)hipGetLastError();
        grid = cus * (per_cu > 1 ? 1 : per_cu);
        if (grid * 256 < 65536) { fprintf(stderr, "kernel_launch: grid %d too small for the GLA scan mapping\n", grid); grid = -1; return; }
    }
    if (grid < 0) return;
    Params p{};
    const float** pp = (const float**)&p;
    for (int i = 0; i < 17; ++i) pp[i] = (const float*)d_in[i];
    p.out = (float*)d_out; p.ws = (unsigned char*)d_ws;
#if MULTI_LAUNCH
    for (int ph = 0; ph < N_PHASES; ++ph) { p.ph_lo = ph; p.ph_hi = ph + 1; hipLaunchKernelGGL(hymba_fwd, dim3(grid), dim3(NTHR), LDS_BYTES, stream, p); }
#else
    p.ph_lo = 0; p.ph_hi = N_PHASES;
    if (hipMemsetAsync((unsigned char*)d_ws + WS_CTL, 0, CTL_BYTES, stream) != hipSuccess) { fprintf(stderr, "kernel_launch: memset of the barrier words failed\n"); return; }
    void* args[] = {&p};
    hipError_t e = hipLaunchCooperativeKernel((const void*)hymba_fwd, dim3(grid), dim3(NTHR), args, LDS_BYTES, stream);
    if (e != hipSuccess) fprintf(stderr, "kernel_launch: cooperative launch failed: %s (grid %d)\n", hipGetErrorString(e), grid);
#endif
}
```

```cpp
#include <hip/hip_runtime.h>
#include <hip/hip_cooperative_groups.h>
#include <cstdio>
#include <cstdint>
namespace cg = cooperative_groups;
#define MULTI_LAUNCH 0

namespace pg8 {
#define PG8_LAS __attribute__((address_space(3)))
typedef unsigned short bf16_t;
typedef short bf16x8 __attribute__((ext_vector_type(8)));
typedef float f32x4 __attribute__((ext_vector_type(4)));
typedef unsigned u32x4 __attribute__((ext_vector_type(4)));
constexpr int BM = 256, BK = 64, HALF = 128, HTB = HALF * BK * 2  , STAGE_BYTES = 8 * HTB, NXCD = 8, WGM = 8;

__host__ __device__ __forceinline__ int lds_byte(int r, int c) { const int st = (r >> 4) * 2 + (c >> 5), rr = r & 15, cc = c & 31, ob = rr * 64 + cc * 2; return st * 1024 + (ob ^ (((ob >> 9) & 1) << 5)); }
__host__ __device__ __forceinline__ void stage_rc(int b, int& R, int& C) { const int st = b / 1024, sb = b % 1024, swz = sb ^ (((sb >> 9) & 1) << 5); R = (st >> 1) * 16 + swz / 64; C = (st & 1) * 32 + (swz % 64) / 2; }
__host__ __device__ __forceinline__ int perm32(int rho) { const int n = rho >> 4, i = rho & 15; return 8 * (i >> 2) + 4 * n + (i & 3); }

struct Unit { int pm, pn, koff; };
struct Gemm { const bf16_t* A; const bf16_t* Bt; int M, N, K, ld; };

struct StaticOrder {
    int nM, nN, nwg, G, c;
    __host__ __device__ void init(int M, int N, int G_, int c_) { nM = M / BM; nN = N / BM; nwg = nM * nN; G = G_; c = c_; }
    __host__ __device__ bool next(int i, Unit& u) const {
        const long L = (long)i * G + c; if (L >= nwg) return false;
        int wgid = (int)L; { const int q = nwg / NXCD, r = nwg % NXCD, xcd = wgid % NXCD, off = wgid / NXCD; wgid = (xcd < r ? xcd * (q + 1) : r * (q + 1) + (xcd - r) * q) + off; }
        const int nig = WGM * nN, gid = wgid / nig, fm = gid * WGM, gsz = (nM - fm) < WGM ? (nM - fm) : WGM;
        u.pm = fm + ((wgid % nig) % gsz); u.pn = (wgid % nig) / gsz; u.koff = 0; return true;
    }
    __device__ __forceinline__ void a_ready(const Unit&) const {}
    __device__ __forceinline__ void done(const Unit&) const {}
};
__device__ __forceinline__ unsigned cvt_pk_bf16(float lo, float hi) { unsigned r; asm volatile("v_cvt_pk_bf16_f32 %0, %1, %2" : "=v"(r) : "v"(lo), "v"(hi)); return r; }

struct EpiF32 {
    static constexpr bool PERM = false, AFTER_DRAIN = false;
    float* O; int ldc;
    __device__ __forceinline__ void operator()(const f32x4 (&acc)[2][2][4][2], const Unit& u, int wr, int wc, int fr, int fq) const {
        const int row0 = u.pm * BM + wr * 64 + fr, col0 = u.pn * BM + wc * 32 + 4 * fq;
#pragma unroll
        for (int ai = 0; ai < 2; ++ai)
#pragma unroll
            for (int m = 0; m < 4; ++m) { float* rowp = O + (size_t)(row0 + ai * HALF + m * 16) * ldc + col0;
#pragma unroll
                for (int bj = 0; bj < 2; ++bj)
#pragma unroll
                    for (int n = 0; n < 2; ++n) *(f32x4*)(rowp + bj * HALF + n * 16) = acc[ai][bj][m][n]; }
    }
};
struct EpiB16 {
    static constexpr bool PERM = true, AFTER_DRAIN = false;
    bf16_t* O; int ldc;
    __device__ __forceinline__ void operator()(const f32x4 (&acc)[2][2][4][2], const Unit& u, int wr, int wc, int fr, int fq) const {
        const int row0 = u.pm * BM + wr * 64 + fr, col0 = u.pn * BM + wc * 32 + 8 * fq;
#pragma unroll
        for (int ai = 0; ai < 2; ++ai)
#pragma unroll
            for (int m = 0; m < 4; ++m) { bf16_t* rowp = O + (size_t)(row0 + ai * HALF + m * 16) * ldc + col0;
#pragma unroll
                for (int bj = 0; bj < 2; ++bj) { const f32x4 v0 = acc[ai][bj][m][0], v1 = acc[ai][bj][m][1];
                    u32x4 w; w.x = cvt_pk_bf16(v0[0], v0[1]); w.y = cvt_pk_bf16(v0[2], v0[3]); w.z = cvt_pk_bf16(v1[0], v1[1]); w.w = cvt_pk_bf16(v1[2], v1[3]);
                    *(u32x4*)(rowp + bj * HALF) = w; } }
    }
};
struct EpiIn {
    static constexpr bool PERM = true, AFTER_DRAIN = false;
    bf16_t* P; int ldc; bf16_t* VtA; bf16_t* VtB; int LPtok; float qscale;
    __device__ __forceinline__ void operator()(const f32x4 (&acc)[2][2][4][2], const Unit& u, int wr, int wc, int fr, int fq) const {
        const int row0 = u.pm * BM + wr * 64 + fr, col0 = u.pn * BM + wc * 32 + 8 * fq;
        const bool isva = (u.pn >= 8 && u.pn < 12), isvb = (u.pn >= 16 && u.pn < 20);
        if (isva || isvb) {
            bf16_t* Vt = isva ? VtA : VtB; const int cbase = col0 - (isva ? 2048 : 4096);
#pragma unroll
            for (int ai = 0; ai < 2; ++ai)
#pragma unroll
                for (int m = 0; m < 4; ++m) { const int row = row0 + ai * HALF + m * 16; const int b = row / LPtok, t = row - b * LPtok;
#pragma unroll
                    for (int bj = 0; bj < 2; ++bj) { const f32x4 v0 = acc[ai][bj][m][0], v1 = acc[ai][bj][m][1];
                        const unsigned w0 = cvt_pk_bf16(v0[0], v0[1]), w1 = cvt_pk_bf16(v0[2], v0[3]), w2 = cvt_pk_bf16(v1[0], v1[1]), w3 = cvt_pk_bf16(v1[2], v1[3]);
                        bf16_t* dst = Vt + ((size_t)b * 1024 + cbase + bj * HALF) * LPtok + t;
                        dst[0] = (bf16_t)(w0 & 0xffffu); dst[(size_t)LPtok] = (bf16_t)(w0 >> 16); dst[(size_t)2 * LPtok] = (bf16_t)(w1 & 0xffffu); dst[(size_t)3 * LPtok] = (bf16_t)(w1 >> 16);
                        dst[(size_t)4 * LPtok] = (bf16_t)(w2 & 0xffffu); dst[(size_t)5 * LPtok] = (bf16_t)(w2 >> 16); dst[(size_t)6 * LPtok] = (bf16_t)(w3 & 0xffffu); dst[(size_t)7 * LPtok] = (bf16_t)(w3 >> 16); } }
        } else {
            const float sc = (u.pn < 4) ? qscale : 1.f;
#pragma unroll
            for (int ai = 0; ai < 2; ++ai)
#pragma unroll
                for (int m = 0; m < 4; ++m) { bf16_t* rowp = P + (size_t)(row0 + ai * HALF + m * 16) * ldc + col0;
#pragma unroll
                    for (int bj = 0; bj < 2; ++bj) { const f32x4 v0 = acc[ai][bj][m][0] * sc, v1 = acc[ai][bj][m][1] * sc;
                        u32x4 w; w.x = cvt_pk_bf16(v0[0], v0[1]); w.y = cvt_pk_bf16(v0[2], v0[3]); w.z = cvt_pk_bf16(v1[0], v1[1]); w.w = cvt_pk_bf16(v1[2], v1[3]);
                        *(u32x4*)(rowp + bj * HALF) = w; } }
        }
    }
};


struct EpiPart {
    static constexpr bool PERM = false, AFTER_DRAIN = false;
    float* O; int ldc; int kpiece;
    __device__ __forceinline__ void operator()(const f32x4 (&acc)[2][2][4][2], const Unit& u, int wr, int wc, int fr, int fq) const {
        const int row0 = wr * 64 + fr, col0 = u.pn * BM + wc * 32 + 4 * fq;
        float* base = O + (size_t)(u.koff / kpiece) * 256 * ldc;
#pragma unroll
        for (int ai = 0; ai < 2; ++ai)
#pragma unroll
            for (int m = 0; m < 4; ++m) { float* rowp = base + (size_t)(row0 + ai * HALF + m * 16) * ldc + col0;
#pragma unroll
                for (int bj = 0; bj < 2; ++bj)
#pragma unroll
                    for (int n = 0; n < 2; ++n) *(f32x4*)(rowp + bj * HALF + n * 16) = acc[ai][bj][m][n]; }
    }
};
struct FullOrder32 {
    int G, c;
    __device__ bool next(int i, Unit& u) const { const int L = c + i * G; if (L >= 256) return false; const int x = L & 7, off = L >> 3; u.pm = 4 * x + (off >> 3); u.pn = off & 7; u.koff = 0; return true; }
    __device__ __forceinline__ void a_ready(const Unit&) const {}
    __device__ __forceinline__ void done(const Unit&) const {}
};
struct SplitOrder32 {
    int G, c, nsplit, kpiece;
    __device__ bool next(int i, Unit& u) const { const int q = c + i * G; if (q >= 8 * nsplit) return false; u.pm = 32; u.pn = q & 7; u.koff = (q >> 3) * kpiece; return true; }
    __device__ __forceinline__ void a_ready(const Unit&) const {}
    __device__ __forceinline__ void done(const Unit&) const {}
};
template <class Epi, class Sched, bool ALIGN_EPI = false, bool SP2 = false>
__device__ __forceinline__ void gemm_phase(PG8_LAS unsigned char* lds, const Gemm g, const Sched& S, const Epi& E) {
    int tid_ = threadIdx.x; asm volatile("" : "+v"(tid_));
    const int tid = tid_, wid = __builtin_amdgcn_readfirstlane(tid >> 6), lane = tid & 63, wr = wid >> 2, wc = wid & 3, fr = lane & 15, fq = lane >> 4;
    const int K = g.K, nt = K / BK, LD = g.ld ? g.ld : g.K;
    unsigned voffA[2], voffB[2];
#pragma unroll
    for (int i = 0; i < 2; ++i) { int R, C; stage_rc(tid * 16 + i * 8192, R, C); const int Rb = Epi::PERM ? ((R & ~31) + perm32(R & 31)) : R;
        voffA[i] = (unsigned)(R * LD + C) * 2u; voffB[i] = (unsigned)(Rb * LD + C) * 2u; }
    const size_t kstep = (size_t)(BK * 2);
    const size_t hstep = (size_t)HALF * LD * 2;
    const size_t tstep = 2 * hstep;
    const unsigned ldsw = (unsigned)wid * 1024u;
    const int aoff = lds_byte(wr * 64 + fr, fq * 8), boff = lds_byte(wc * 32 + fr, fq * 8);
#define PG8_SA(b, h) (((b) * 2 + (h)) * HTB)
#define PG8_SB(b, h) ((4 + (b) * 2 + (h)) * HTB)
#define PG8_STAGE(bufoff, gbase, voff) do { _Pragma("unroll") for (int _i = 0; _i < 2; ++_i) \
        __builtin_amdgcn_global_load_lds((const unsigned*)((const char*)(gbase) + (voff)[_i]), (PG8_LAS unsigned*)(lds + (bufoff) + ldsw + _i * 8192), 16, 0, 0); } while (0)
#define PG8_LDA(dst, b, h) do { _Pragma("unroll") for (int m = 0; m < 4; ++m) _Pragma("unroll") for (int k = 0; k < 2; ++k) dst[m][k] = *(const PG8_LAS bf16x8*)(lds + PG8_SA(b, h) + aoff + m * 2048 + k * 1024); } while (0)
#define PG8_LDB(dst, b, h) do { _Pragma("unroll") for (int n = 0; n < 2; ++n) _Pragma("unroll") for (int k = 0; k < 2; ++k) dst[n][k] = *(const PG8_LAS bf16x8*)(lds + PG8_SB(b, h) + boff + n * 2048 + k * 1024); } while (0)
#define PG8_MMA(ai, bj, At, Bt) do { __builtin_amdgcn_s_setprio(1); _Pragma("unroll") for (int m = 0; m < 4; ++m) _Pragma("unroll") for (int n = 0; n < 2; ++n) _Pragma("unroll") for (int k = 0; k < 2; ++k) \
        acc[ai][bj][m][n] = __builtin_amdgcn_mfma_f32_16x16x32_bf16(Bt[n][k], At[m][k], acc[ai][bj][m][n], 0, 0, 0); __builtin_amdgcn_s_setprio(0); } while (0)
#define PG8_WAIT_V(n) asm volatile("s_waitcnt vmcnt(" #n ")" ::: "memory")
#define PG8_WAIT_L(n) asm volatile("s_waitcnt lgkmcnt(" #n ")" ::: "memory")
#define PG8_BAR __builtin_amdgcn_s_barrier()
#define PG8_SCHED __builtin_amdgcn_sched_barrier(0)
    Unit cur, nxt; int ui = 0;
    if (!S.next(0, cur)) return;
    f32x4 acc[2][2][4][2];
#pragma unroll
    for (int a = 0; a < 2; ++a)
#pragma unroll
        for (int b = 0; b < 2; ++b)
#pragma unroll
            for (int m = 0; m < 4; ++m)
#pragma unroll
                for (int n = 0; n < 2; ++n) acc[a][b][m][n] = (f32x4){0.f, 0.f, 0.f, 0.f};
    bf16x8 At[4][2], B0[2][2], B1[2][2];
    const char* cA = (const char*)g.A + (size_t)cur.pm * tstep + (size_t)cur.koff * 2; const char* cB = (const char*)g.Bt + (size_t)cur.pn * tstep + (size_t)cur.koff * 2;
    S.a_ready(cur);
    if constexpr (SP2) {
        PG8_STAGE(PG8_SB(0, 0), cB, voffB); PG8_STAGE(PG8_SB(0, 1), cB + hstep, voffB); PG8_STAGE(PG8_SA(0, 0), cA, voffA); PG8_STAGE(PG8_SA(0, 1), cA + hstep, voffA);
        if (wr == 1) PG8_BAR;
        PG8_WAIT_V(2); PG8_BAR;
        PG8_STAGE(PG8_SB(1, 0), cB + kstep, voffB); PG8_STAGE(PG8_SA(1, 0), cA + kstep, voffA); PG8_STAGE(PG8_SB(1, 1), cB + hstep + kstep, voffB);
        PG8_WAIT_V(6); PG8_BAR;
    } else {
        PG8_STAGE(PG8_SB(0, 0), cB, voffB); PG8_STAGE(PG8_SA(0, 0), cA, voffA); PG8_STAGE(PG8_SB(0, 1), cB + hstep, voffB); PG8_STAGE(PG8_SA(0, 1), cA + hstep, voffA);
        if (wr == 1) PG8_BAR;
        PG8_WAIT_V(4); PG8_BAR;
        PG8_STAGE(PG8_SB(1, 0), cB + kstep, voffB); PG8_STAGE(PG8_SA(1, 0), cA + kstep, voffA); PG8_STAGE(PG8_SB(1, 1), cB + hstep + kstep, voffB);
        PG8_WAIT_V(6); PG8_BAR;
    }
    for (;;) {
        const bool has_next = S.next(ui + 1, nxt);
        const char* nA = has_next ? (const char*)g.A + (size_t)nxt.pm * tstep + (size_t)nxt.koff * 2 : cA; const char* nB = has_next ? (const char*)g.Bt + (size_t)nxt.pn * tstep + (size_t)nxt.koff * 2 : cB;
        for (int t = 0; t < nt; t += 2) {
            const bool last = (t == nt - 2);
            const char* a1 = cA + (size_t)(t + 1) * kstep;
            const char* a2 = last ? nA : cA + (size_t)(t + 2) * kstep; const char* b2 = last ? nB : cB + (size_t)(t + 2) * kstep;
            const char* a3 = a2 + kstep; const char* b3 = b2 + kstep;
            if (last && has_next) S.a_ready(nxt);
            if constexpr (SP2) {
            PG8_LDB(B0, 0, 0); PG8_LDB(B1, 0, 1); PG8_SCHED; PG8_LDA(At, 0, 0); PG8_STAGE(PG8_SA(1, 1), a1 + hstep, voffA);
            PG8_WAIT_V(8); PG8_WAIT_L(0); PG8_BAR; PG8_MMA(0, 0, At, B0); PG8_MMA(0, 1, At, B1); PG8_BAR; PG8_SCHED;
            PG8_LDA(At, 0, 1); PG8_STAGE(PG8_SB(0, 0), b2, voffB); PG8_STAGE(PG8_SB(0, 1), b2 + hstep, voffB); PG8_STAGE(PG8_SA(0, 0), a2, voffA);
            PG8_WAIT_V(8); PG8_WAIT_L(0); PG8_BAR; PG8_MMA(1, 0, At, B0); PG8_MMA(1, 1, At, B1); PG8_BAR; PG8_SCHED;
            PG8_LDB(B0, 1, 0); PG8_LDB(B1, 1, 1); PG8_SCHED; PG8_LDA(At, 1, 0); PG8_STAGE(PG8_SA(0, 1), a2 + hstep, voffA);
            PG8_WAIT_V(8); PG8_WAIT_L(0); PG8_BAR; PG8_MMA(0, 0, At, B0); PG8_MMA(0, 1, At, B1); PG8_BAR; PG8_SCHED;
            PG8_LDA(At, 1, 1); PG8_STAGE(PG8_SB(1, 0), b3, voffB); PG8_STAGE(PG8_SB(1, 1), b3 + hstep, voffB); PG8_STAGE(PG8_SA(1, 0), a3, voffA);
            PG8_WAIT_V(8); PG8_WAIT_L(0); PG8_BAR; PG8_MMA(1, 0, At, B0); PG8_MMA(1, 1, At, B1); PG8_BAR; PG8_SCHED;
            } else {
            PG8_LDB(B0, 0, 0); PG8_SCHED; PG8_LDA(At, 0, 0); PG8_STAGE(PG8_SA(1, 1), a1 + hstep, voffA);
            PG8_WAIT_L(8); PG8_BAR; PG8_WAIT_L(0); PG8_MMA(0, 0, At, B0); PG8_BAR; PG8_SCHED;
            PG8_LDB(B1, 0, 1); PG8_STAGE(PG8_SB(0, 0), b2, voffB);
            PG8_BAR; PG8_WAIT_L(0); PG8_MMA(0, 1, At, B1); PG8_BAR;
            PG8_LDA(At, 0, 1); PG8_STAGE(PG8_SA(0, 0), a2, voffA);
            PG8_BAR; PG8_WAIT_L(0); PG8_MMA(1, 0, At, B0); PG8_BAR; PG8_SCHED;
            PG8_STAGE(PG8_SB(0, 1), b2 + hstep, voffB);
            PG8_WAIT_V(6); PG8_BAR; PG8_MMA(1, 1, At, B1); PG8_BAR;
            PG8_LDB(B0, 1, 0); PG8_SCHED; PG8_LDA(At, 1, 0); PG8_STAGE(PG8_SA(0, 1), a2 + hstep, voffA);
            PG8_WAIT_L(8); PG8_BAR; PG8_WAIT_L(0); PG8_MMA(0, 0, At, B0); PG8_BAR; PG8_SCHED;
            PG8_LDB(B1, 1, 1); PG8_STAGE(PG8_SB(1, 0), b3, voffB);
            PG8_BAR; PG8_WAIT_L(0); PG8_MMA(0, 1, At, B1); PG8_BAR;
            PG8_LDA(At, 1, 1); PG8_STAGE(PG8_SA(1, 0), a3, voffA);
            PG8_BAR; PG8_WAIT_L(0); PG8_MMA(1, 0, At, B0); PG8_BAR; PG8_SCHED;
            PG8_STAGE(PG8_SB(1, 1), b3 + hstep, voffB);
            PG8_WAIT_V(6); PG8_BAR; PG8_MMA(1, 1, At, B1); PG8_BAR;
            }
        }
        if constexpr (ALIGN_EPI) { if (wr == 0) PG8_BAR; }
        if constexpr (!Epi::AFTER_DRAIN) { E(acc, cur, wr, wc, fr, fq); S.done(cur); }
        if (!has_next) break;
#pragma unroll
        for (int a = 0; a < 2; ++a)
#pragma unroll
            for (int b = 0; b < 2; ++b)
#pragma unroll
                for (int m = 0; m < 4; ++m)
#pragma unroll
                    for (int n = 0; n < 2; ++n) acc[a][b][m][n] = (f32x4){0.f, 0.f, 0.f, 0.f};
        cur = nxt; cA = nA; cB = nB; ++ui;
        if constexpr (ALIGN_EPI) { if (wr == 1) PG8_BAR; }
    }
    PG8_WAIT_V(0);
    if constexpr (!ALIGN_EPI) { if (wr == 0) PG8_BAR; }
    PG8_BAR;
    if constexpr (Epi::AFTER_DRAIN) { E.fused(acc, cur, wr, wc, fr, fq, lds, wid, lane); S.done(cur); }
#undef PG8_SA
#undef PG8_SB
#undef PG8_STAGE
#undef PG8_LDA
#undef PG8_LDB
#undef PG8_MMA
#undef PG8_WAIT_V
#undef PG8_WAIT_L
#undef PG8_BAR
#undef PG8_SCHED
}
}

#define LAS __attribute__((address_space(3)))
typedef unsigned short bf16_t;
typedef short bf16x8 __attribute__((ext_vector_type(8)));
typedef float f32x4 __attribute__((ext_vector_type(4)));
typedef float f32x16 __attribute__((ext_vector_type(16)));
typedef unsigned u32x4 __attribute__((ext_vector_type(4)));
typedef unsigned u32x2 __attribute__((ext_vector_type(2)));
typedef float f32x2_t __attribute__((ext_vector_type(2)));
typedef __bf16 bf16x2_t __attribute__((ext_vector_type(2)));

constexpr int DM = 2048, NB = 4, SEQ = 2048, DEPTH = 4, NMETA = 16;
constexpr int LT = SEQ + NMETA;
constexpr int LP = 2112;
constexpr int MP = NB * LP;
constexpr int INC = 6160, INP = 6400;
constexpr int DFF = 5632, DFF2 = 11264;
constexpr float EPS = 1e-6f;
constexpr int NTHR = 512, NWAVE = 8;
constexpr int LDS_BYTES = 135168;

constexpr size_t al256(size_t x) { return (x + 255) & ~(size_t)255; }
constexpr size_t SZ_WIN = (size_t)INP * DM * 2, SZ_WOUT = (size_t)DM * DM * 2, SZ_WUP = (size_t)DFF2 * DM * 2, SZ_WDN = (size_t)DM * DFF * 2;
constexpr size_t WS_WIN = 0;
constexpr size_t WS_WOUT = WS_WIN + DEPTH * SZ_WIN;
constexpr size_t WS_WUP = WS_WOUT + DEPTH * SZ_WOUT;
constexpr size_t WS_WDN = WS_WUP + DEPTH * SZ_WUP;
constexpr size_t WS_X = WS_WDN + DEPTH * SZ_WDN;
constexpr size_t WS_H = WS_X + (size_t)MP * DM * 4;
constexpr size_t WS_P = WS_H + (size_t)MP * DM * 2;
constexpr size_t WS_VTA = WS_P + (size_t)MP * INP * 2;
constexpr size_t WS_VTB = WS_VTA + al256((size_t)NB * 1024 * LP * 2 + 4096);
constexpr size_t WS_OC = WS_VTB + al256((size_t)NB * 1024 * LP * 2 + 4096);
constexpr size_t WS_Y = WS_OC + (size_t)MP * DM * 2;
constexpr size_t WS_U = WS_Y + (size_t)MP * DM * 4;
constexpr size_t WS_G = WS_U + (size_t)MP * DFF2 * 2;
constexpr size_t WS_KV = WS_G + (size_t)MP * DFF * 2;
constexpr size_t WS_SP = WS_KV + (size_t)528 * 32768 * 4;
constexpr size_t WS_DEC = WS_SP + (size_t)528 * 65536;
constexpr size_t WS_PART = WS_DEC + (size_t)528 * 128 * 4;
constexpr size_t WS_CTL = WS_PART + (size_t)22 * 256 * DM * 4;
constexpr size_t CTL_BYTES = 16384;
constexpr size_t WS_END = WS_CTL + CTL_BYTES;

struct Params {
    const float *x, *meta, *pre_mix_g, *w_in, *da_lambda, *da_subln_g, *gate_w2, *gate_b, *gla_norm_g, *w_out, *post_mix_g, *pre_ffn_g, *w_up, *conv_w, *conv_b, *w_down, *post_ffn_g;
    float* out; unsigned char* ws; int ph_lo, ph_hi;
};

__device__ __forceinline__ unsigned pack2(float lo, float hi) { f32x2_t v = {lo, hi}; bf16x2_t b = __builtin_convertvector(v, bf16x2_t); return __builtin_bit_cast(unsigned, b); }
__device__ __forceinline__ float bf2f(unsigned short u) { return __uint_as_float(((unsigned)u) << 16); }
__device__ __forceinline__ float bflo(unsigned u) { return __uint_as_float(u << 16); }
__device__ __forceinline__ float bfhi(unsigned u) { return __uint_as_float(u & 0xffff0000u); }
__device__ __forceinline__ float wave_sum(float v) {
#pragma unroll
    for (int o = 1; o < 64; o <<= 1) v += __shfl_xor(v, o);
    return v;
}
#define MFMA32(a, b, c) __builtin_amdgcn_mfma_f32_32x32x16_bf16((a), (b), (c), 0, 0, 0)
__device__ __forceinline__ bf16x8 pack8(const f32x16& x, int s) {
    u32x4 p; p.x = pack2(x[8 * s + 0], x[8 * s + 1]); p.y = pack2(x[8 * s + 2], x[8 * s + 3]); p.z = pack2(x[8 * s + 4], x[8 * s + 5]); p.w = pack2(x[8 * s + 6], x[8 * s + 7]);
    return __builtin_bit_cast(bf16x8, p);
}
__device__ __forceinline__ int swap23(int i) { return (i & ~12) | ((i & 4) << 1) | ((i & 8) >> 1); }
__device__ __forceinline__ int crow(int r, int hi) { return (r & 3) + 8 * (r >> 2) + 4 * hi; }

struct TItem { const float* W; bf16_t* WT; int K, Nsrc, k0, n0; };
__device__ __forceinline__ void titem_load(const TItem& ti, float (&r)[64], int lane) {
    const int n = ti.n0 + lane; const bool ok = n < ti.Nsrc;
    const float* src = ti.W + (size_t)ti.k0 * ti.Nsrc + n;
#pragma unroll
    for (int i = 0; i < 64; ++i) r[i] = ok ? src[(size_t)i * ti.Nsrc] : 0.f;
}
__device__ __forceinline__ void titem_store(const TItem& ti, const float (&r)[64], LAS float* scr, int lane) {
#pragma unroll
    for (int i = 0; i < 64; ++i) scr[i * 65 + lane] = r[i];
    asm volatile("s_waitcnt lgkmcnt(0)" ::: "memory");
    const int c = lane & 7;
#pragma unroll
    for (int j = 0; j < 8; ++j) { const int nn = (lane >> 3) + 8 * j; const LAS float* s = scr + (8 * c) * 65 + nn;
        u32x4 o; o.x = pack2(s[0 * 65], s[1 * 65]); o.y = pack2(s[2 * 65], s[3 * 65]); o.z = pack2(s[4 * 65], s[5 * 65]); o.w = pack2(s[6 * 65], s[7 * 65]);
        *(u32x4*)(ti.WT + (size_t)(ti.n0 + nn) * ti.K + ti.k0 + 8 * c) = o; }
    asm volatile("s_waitcnt lgkmcnt(0)" ::: "memory");
}

template <int MODE>
__device__ __forceinline__ void row_phase(const float* xin, const float* meta, float* outp, float* X, float* Xw, const float* Y, const float* PART, int nsplit, bf16_t* H, const float* g1, const float* g2, int gw, int ngw, int lane) {
    for (int row = gw; row < MP; row += ngw) {
        const int b = row / LP, t = row - b * LP;
        f32x4 xv[8];
        float* xr = X + (size_t)row * DM;
        if (MODE == 0) {
            const float* src = (t < NMETA) ? meta + (size_t)t * DM : xin + ((size_t)b * SEQ + (t - NMETA)) * DM;
#pragma unroll
            for (int j = 0; j < 8; ++j) xv[j] = (t < LT) ? *(const f32x4*)(src + 4 * (lane + 64 * j)) : (f32x4){0.f, 0.f, 0.f, 0.f};
        } else {
            const float* yr = Y + (size_t)row * DM;
            f32x4 yv[8]; float ss = 0.f;
            if (row >= 8192) {
#pragma unroll
                for (int j = 0; j < 8; ++j) yv[j] = (f32x4){0.f, 0.f, 0.f, 0.f};
                for (int kp = 0; kp < nsplit; ++kp) { const float* pr = PART + ((size_t)kp * 256 + (row - 8192)) * DM;
#pragma unroll
                    for (int j = 0; j < 8; ++j) yv[j] += *(const f32x4*)(pr + 4 * (lane + 64 * j)); }
            } else {
#pragma unroll
                for (int j = 0; j < 8; ++j) yv[j] = *(const f32x4*)(yr + 4 * (lane + 64 * j));
            }
#pragma unroll
            for (int j = 0; j < 8; ++j) { ss += (yv[j].x * yv[j].x + yv[j].y * yv[j].y) + (yv[j].z * yv[j].z + yv[j].w * yv[j].w); }
            const float r1 = rsqrtf(wave_sum(ss) * (1.f / DM) + EPS);
#pragma unroll
            for (int j = 0; j < 8; ++j) { const f32x4 g = *(const f32x4*)(g1 + 4 * (lane + 64 * j)); const f32x4 xo = *(const f32x4*)(xr + 4 * (lane + 64 * j)); xv[j] = xo + yv[j] * r1 * g; }
        }
        if (MODE == 2) {
            if (t >= NMETA && t < LT) { float* orow = outp + ((size_t)b * SEQ + (t - NMETA)) * DM;
#pragma unroll
                for (int j = 0; j < 8; ++j) *(f32x4*)(orow + 4 * (lane + 64 * j)) = xv[j]; }
        } else {
            float ss = 0.f;
            float* xw = Xw + (size_t)row * DM;
#pragma unroll
            for (int j = 0; j < 8; ++j) { *(f32x4*)(xw + 4 * (lane + 64 * j)) = xv[j]; ss += (xv[j].x * xv[j].x + xv[j].y * xv[j].y) + (xv[j].z * xv[j].z + xv[j].w * xv[j].w); }
            const float r2 = rsqrtf(wave_sum(ss) * (1.f / DM) + EPS);
            bf16_t* hr = H + (size_t)row * DM;
#pragma unroll
            for (int j = 0; j < 8; ++j) { const f32x4 g = *(const f32x4*)(g2 + 4 * (lane + 64 * j)); const f32x4 v = xv[j] * r2 * g;
                u32x2 w; w.x = pack2(v.x, v.y); w.y = pack2(v.z, v.w); *(u32x2*)(hr + 4 * (lane + 64 * j)) = w; }
        }
    }
}

__device__ __forceinline__ void conv_phase(const bf16_t* U, bf16_t* G, const float* cw, const float* cb, int gtid, int ngt) {
    constexpr int NCG = DFF / 8, NSTRIP = MP / 16;
    for (int it = gtid; it < NCG * NSTRIP; it += ngt) {
        const int s = it / NCG, cgp = it - s * NCG, j0 = 8 * cgp, row0 = 16 * s; const int t0 = row0 % LP;
        float wa[3][8], wv[3][8], ba[8], bv[8];
#pragma unroll
        for (int i = 0; i < 3; ++i)
#pragma unroll
            for (int e = 0; e < 8; e += 4) { const f32x4 a = *(const f32x4*)(cw + (size_t)i * DFF2 + j0 + e), v = *(const f32x4*)(cw + (size_t)i * DFF2 + DFF + j0 + e);
                wa[i][e] = a.x; wa[i][e + 1] = a.y; wa[i][e + 2] = a.z; wa[i][e + 3] = a.w; wv[i][e] = v.x; wv[i][e + 1] = v.y; wv[i][e + 2] = v.z; wv[i][e + 3] = v.w; }
#pragma unroll
        for (int e = 0; e < 8; e += 4) { const f32x4 a = *(const f32x4*)(cb + j0 + e), v = *(const f32x4*)(cb + DFF + j0 + e);
            ba[e] = a.x; ba[e + 1] = a.y; ba[e + 2] = a.z; ba[e + 3] = a.w; bv[e] = v.x; bv[e + 1] = v.y; bv[e + 2] = v.z; bv[e + 3] = v.w; }
        u32x4 a2 = {0, 0, 0, 0}, a1 = {0, 0, 0, 0}, v2 = {0, 0, 0, 0}, v1 = {0, 0, 0, 0};
        if (t0 > 0) { const bf16_t* u = U + (size_t)(row0 - 2) * DFF2 + j0; a2 = *(const u32x4*)u; v2 = *(const u32x4*)(u + DFF); a1 = *(const u32x4*)(u + DFF2); v1 = *(const u32x4*)(u + DFF2 + DFF); }
#pragma unroll 4
        for (int r = 0; r < 16; ++r) {
            const bf16_t* u = U + (size_t)(row0 + r) * DFF2 + j0;
            const u32x4 a0 = *(const u32x4*)u, v0 = *(const u32x4*)(u + DFF);
            unsigned ow[4];
#pragma unroll
            for (int q = 0; q < 4; ++q) {
                const float al = ba[2 * q] + wa[0][2 * q] * bflo(a2[q]) + wa[1][2 * q] * bflo(a1[q]) + wa[2][2 * q] * bflo(a0[q]);
                const float ah = ba[2 * q + 1] + wa[0][2 * q + 1] * bfhi(a2[q]) + wa[1][2 * q + 1] * bfhi(a1[q]) + wa[2][2 * q + 1] * bfhi(a0[q]);
                const float vl = bv[2 * q] + wv[0][2 * q] * bflo(v2[q]) + wv[1][2 * q] * bflo(v1[q]) + wv[2][2 * q] * bflo(v0[q]);
                const float vh = bv[2 * q + 1] + wv[0][2 * q + 1] * bfhi(v2[q]) + wv[1][2 * q + 1] * bfhi(v1[q]) + wv[2][2 * q + 1] * bfhi(v0[q]);
                const float gl = al / (1.f + __expf(-al)) * vl, gh = ah / (1.f + __expf(-ah)) * vh;
                ow[q] = pack2(gl, gh);
            }
            *(u32x4*)(G + (size_t)(row0 + r) * DFF + j0) = (u32x4){ow[0], ow[1], ow[2], ow[3]};
            a2 = a1; a1 = a0; v2 = v1; v1 = v0;
        }
    }
}
#define XB_TMO      128
#define XB_XCNT(j)  (256  + 64 * (j))
#define XB_XSUB(j)  (1280 + 64 * (j))
#define XB_XGEN(j)  (2304 + 64 * (j))
#define XB_TOP      3328
#define XB_TOPGEN   3392
#define XCD_BAR_WORDS 3456
#define XB_SPIN_CAP (1u << 18)

__device__ __forceinline__ unsigned xb_ld(unsigned* p)              { return __hip_atomic_load(p, __ATOMIC_RELAXED, __HIP_MEMORY_SCOPE_AGENT); }
__device__ __forceinline__ unsigned xb_add(unsigned* p, unsigned v) { return __hip_atomic_fetch_add(p, v, __ATOMIC_RELAXED, __HIP_MEMORY_SCOPE_AGENT); }
__device__ __forceinline__ unsigned xb_xcc_id() { return (unsigned)__builtin_amdgcn_s_getreg((3 << 11) | 20) & 0xFu; }
#define XB_SPIN(cond, bar) do { unsigned _sp = 0; while (cond) { __builtin_amdgcn_s_sleep(1); \
    if ((++_sp & 255u) == 0u) { if (xb_ld(&(bar)[XB_TMO])) break; if (_sp > XB_SPIN_CAP) { atomicAdd(&(bar)[XB_TMO], 1u); break; } } } } while (0)

struct XcdBarrier {
    unsigned* bar; unsigned x;
    volatile LAS unsigned* st;
};

__device__ __forceinline__ XcdBarrier xcd_barrier_post(unsigned* bar, volatile LAS unsigned* st) {
    XcdBarrier b; b.bar = bar; b.x = xb_xcc_id(); b.st = st;
    if (threadIdx.x == 0) (void)xb_add(&bar[XB_XCNT(b.x)], 1u);
    return b;
}
__device__ __forceinline__ void xcd_barrier_complete(unsigned* bar, unsigned x, unsigned& nloc, unsigned& nx) {
    const unsigned G = gridDim.x * gridDim.y * gridDim.z;
    unsigned sum, cnt, mine, sp = 0u;
    for (;;) {
        sum = 0u; cnt = 0u; mine = 0u;
#pragma unroll
        for (unsigned j = 0; j < 16; ++j) { const unsigned c = xb_ld(&bar[XB_XCNT(j)]); sum += c; cnt += (c > 0u) ? 1u : 0u; mine = (j == x) ? c : mine; }
        if (sum == G) break;
        __builtin_amdgcn_s_sleep(1);
        if ((++sp & 255u) == 0u) { if (xb_ld(&bar[XB_TMO])) break; if (sp > XB_SPIN_CAP) { atomicAdd(&bar[XB_TMO], 1u); break; } }
    }
    nloc = mine > 0u ? mine : 1u; nx = cnt > 0u ? cnt : 1u;
}

__device__ __forceinline__ void xcd_barrier(const XcdBarrier& b) {
    asm volatile("s_waitcnt vmcnt(0)" ::: "memory");
    __syncthreads();
    if (threadIdx.x == 0) {
        unsigned* bar = b.bar;
        __builtin_amdgcn_s_waitcnt(0);
        unsigned nloc = b.st[0], nx = b.st[1];
        if (nloc == 0u) { xcd_barrier_complete(bar, b.x, nloc, nx); b.st[0] = nloc; b.st[1] = nx; }
        const unsigned old = xb_add(&bar[XB_XSUB(b.x)], 1u);
        const unsigned gen = old / nloc;
        if (old + 1u == (gen + 1u) * nloc) {
            __builtin_amdgcn_fence(__ATOMIC_RELEASE, "agent");
            asm volatile("s_waitcnt vmcnt(0)" ::: "memory");
            const unsigned og = xb_add(&bar[XB_TOP], 1u);
            const unsigned tg = og / nx;
            if (og + 1u == (tg + 1u) * nx) xb_add(&bar[XB_TOPGEN], 1u);
            else XB_SPIN(xb_ld(&bar[XB_TOPGEN]) == tg, bar);
            __builtin_amdgcn_fence(__ATOMIC_ACQUIRE, "agent");
            xb_add(&bar[XB_XGEN(b.x)], 1u);
            asm volatile("s_waitcnt vmcnt(0)" ::: "memory");
        } else {
            XB_SPIN(xb_ld(&bar[XB_XGEN(b.x)]) == gen, bar);
            __builtin_amdgcn_fence(__ATOMIC_ACQUIRE, "agent");
            asm volatile("s_waitcnt vmcnt(0)" ::: "memory");
        }
    }
    __syncthreads();
}

constexpr int AT_KSTR = 144, AT_K1 = 64 * AT_KSTR  , AT_VOFF = 2 * AT_K1  , AT_BUF = AT_VOFF + 128 * AT_KSTR  ;
__device__ __forceinline__ void attn_unit(unsigned char* lds, const bf16_t* __restrict__ P, const bf16_t* __restrict__ Vt, bf16_t* __restrict__ OC, const float* subg_lds,
                                          int b, int h, int qt, float lam, float omli) {
    int tid_ = threadIdx.x; asm volatile("" : "+v"(tid_));
    const int tid = tid_, lane = tid & 63, w = __builtin_amdgcn_readfirstlane(tid >> 6), l31 = lane & 31, hi = lane >> 5;
    const int c = w >> 2, qb = w & 3;
    const int nkt = (2 * qt + 2 < 33) ? 2 * qt + 2 : 33;
    const int qrow0 = 128 * qt + 32 * qb;
    const bool active = qrow0 < LP;
    bf16x8 qf[4];
    {
        const bf16_t* qp = P + (size_t)(b * LP + (active ? qrow0 : 0) + l31) * INP + h * 128 + c * 64 + hi * 8;
#pragma unroll
        for (int ks = 0; ks < 4; ++ks) qf[ks] = *(const bf16x8*)(qp + 16 * ks);
    }
    f32x16 O[4];
#pragma unroll
    for (int v = 0; v < 4; ++v)
#pragma unroll
        for (int r = 0; r < 16; ++r) O[v][r] = 0.f;
    float m = -INFINITY, l = 0.f;
    const bf16_t* kbase = P + (size_t)(b * LP) * INP + 1024 + h * 128;
    const bf16_t* vbase = Vt + (size_t)(b * 1024 + h * 128) * LP;
    const int kkey0 = tid >> 4, kch = tid & 15;
    const int vdv0 = tid >> 3, vch = tid & 7;
    const bf16_t* ksrc = kbase + (size_t)kkey0 * INP + kch * 8;
    const bf16_t* vsrc = vbase + (size_t)vdv0 * LP + vch * 8;
    const int kdst = (kch >> 3) * AT_K1 + kkey0 * AT_KSTR + (kch & 7) * 16;
    const int vdst = AT_VOFF + vdv0 * AT_KSTR + vch * 16;
    u32x4 tk0, tk1, tv0, tv1;
#define AT_LOAD(kt) do { const bf16_t* ks_ = ksrc + (size_t)(64 * (kt)) * INP; tk0 = *(const u32x4*)ks_; tk1 = *(const u32x4*)(ks_ + (size_t)32 * INP); \
        const bf16_t* vs_ = vsrc + 64 * (kt); tv0 = *(const u32x4*)vs_; tv1 = *(const u32x4*)(vs_ + (size_t)64 * LP); } while (0)
#define AT_STORE(buf) do { unsigned char* d_ = lds + (buf) * AT_BUF; *(u32x4*)(d_ + kdst) = tk0; *(u32x4*)(d_ + kdst + 32 * AT_KSTR) = tk1; \
        *(u32x4*)(d_ + vdst) = tv0; *(u32x4*)(d_ + vdst + 64 * AT_KSTR) = tv1; } while (0)
    AT_LOAD(0); AT_STORE(0);
    __syncthreads();
    const int krow_off = c * AT_K1 + swap23(l31) * AT_KSTR + hi * 16;
    const int vrow_off = AT_VOFF + l31 * AT_KSTR + hi * 16;
    for (int kt = 0; kt < nkt; ++kt) {
        const bool more = kt + 1 < nkt;
        if (more) AT_LOAD(kt + 1);
        const unsigned char* buf = lds + (kt & 1) * AT_BUF;
        if (active && 64 * kt <= qrow0 + 31) {
            f32x16 s0, s1;
#pragma unroll
            for (int r = 0; r < 16; ++r) { s0[r] = 0.f; s1[r] = 0.f; }
#pragma unroll
            for (int ks = 0; ks < 4; ++ks) {
                const bf16x8 k0 = *(const bf16x8*)(buf + krow_off + ks * 32), k1 = *(const bf16x8*)(buf + krow_off + 32 * AT_KSTR + ks * 32);
                s0 = MFMA32(k0, qf[ks], s0); s1 = MFMA32(k1, qf[ks], s1);
            }
            if (64 * kt + 63 > qrow0) {
                const int q = qrow0 + l31, kb0 = 64 * kt + 8 * hi;
#pragma unroll
                for (int r = 0; r < 16; ++r) { const int key = kb0 + 16 * (r >> 3) + (r & 7); if (key > q) s0[r] = -INFINITY; if (key + 32 > q) s1[r] = -INFINITY; }
            }
            float mx = fmaxf(s0[0], s1[0]);
#pragma unroll
            for (int r = 1; r < 16; ++r) mx = fmaxf(mx, fmaxf(s0[r], s1[r]));
            mx = fmaxf(mx, __shfl_xor(mx, 32));
            const float mn = fmaxf(m, mx), alpha = __builtin_amdgcn_exp2f(m - mn);
            m = mn;
            float sum = 0.f;
#pragma unroll
            for (int r = 0; r < 16; ++r) { s0[r] = __builtin_amdgcn_exp2f(s0[r] - mn); s1[r] = __builtin_amdgcn_exp2f(s1[r] - mn); sum += s0[r] + s1[r]; }
            l = l * alpha + sum;
#pragma unroll
            for (int v = 0; v < 4; ++v)
#pragma unroll
                for (int r = 0; r < 16; ++r) O[v][r] *= alpha;
            const bf16x8 p00 = pack8(s0, 0), p01 = pack8(s0, 1), p10 = pack8(s1, 0), p11 = pack8(s1, 1);
#pragma unroll
            for (int v = 0; v < 4; ++v) {
                const unsigned char* vp = buf + vrow_off + v * 32 * AT_KSTR;
                const bf16x8 a0 = *(const bf16x8*)(vp), a1 = *(const bf16x8*)(vp + 32), a2 = *(const bf16x8*)(vp + 64), a3 = *(const bf16x8*)(vp + 96);
                O[v] = MFMA32(a0, p00, O[v]); O[v] = MFMA32(a1, p01, O[v]); O[v] = MFMA32(a2, p10, O[v]); O[v] = MFMA32(a3, p11, O[v]);
            }
        }
        if (more) AT_STORE((kt + 1) & 1);
        __syncthreads();
    }
#undef AT_LOAD
#undef AT_STORE
    l += __shfl_xor(l, 32);
    const float inv = 1.f / l;
    float* ex = (float*)lds + (size_t)qb * 4096;
    if (c == 1 && active) {
#pragma unroll
        for (int v = 0; v < 4; ++v)
#pragma unroll
            for (int r = 0; r < 16; ++r) ex[(v * 16 + r) * 64 + lane] = O[v][r] * inv;
    }
    __syncthreads();
    if (c == 0 && active) {
        float ss = 0.f;
#pragma unroll
        for (int v = 0; v < 4; ++v)
#pragma unroll
            for (int r = 0; r < 16; ++r) { const float o = O[v][r] * inv - lam * ex[(v * 16 + r) * 64 + lane]; O[v][r] = o; ss += o * o; }
        ss += __shfl_xor(ss, 32);
        const float rs = rsqrtf(ss * (1.f / 128.f) + EPS) * omli;
        bf16_t* orow = OC + (size_t)(b * LP + qrow0 + l31) * DM + h * 128;
#pragma unroll
        for (int v = 0; v < 4; ++v)
#pragma unroll
            for (int r4 = 0; r4 < 4; ++r4) { const int dv = 32 * v + 8 * r4 + 4 * hi; const f32x4 g = *(const f32x4*)(subg_lds + dv);
                u32x2 wv; wv.x = pack2(O[v][4 * r4] * rs * g.x, O[v][4 * r4 + 1] * rs * g.y); wv.y = pack2(O[v][4 * r4 + 2] * rs * g.z, O[v][4 * r4 + 3] * rs * g.w);
                *(u32x2*)(orow + dv) = wv; }
    }
    __syncthreads();
}

constexpr int GL_QSTR = 272, GL_TSTR = 144;
constexpr int GL_QIN = 0, GL_KIN = 64 * GL_QSTR  , GL_KOUT = 2 * 64 * GL_QSTR  , GL_VT = GL_KOUT + 128 * GL_TSTR  , GL_LR = GL_VT + 256 * GL_TSTR  ,
              GL_SEG = GL_LR + 4096, GL_DEC = GL_SEG + 2048, GL_NG = GL_DEC + 512, GL_RAWQ = GL_NG + 1024  , GL_RAWK = GL_RAWQ + 16384, GL_END = GL_RAWK + 16384  ;
constexpr int GL_OSTR = 260;
constexpr int NCHUNK = LP / 64, NGU = 16 * NCHUNK;

#define GL_GATE() \
        float bc[16]; float run = 0.f; \
        _Pragma("unroll") for (int i = 0; i < 16; ++i) { \
            const float* lr = LR + (16 * seg + i) * 16; float z = b2r; \
            _Pragma("unroll") for (int j = 0; j < 16; j += 4) { const f32x4 v = *(const f32x4*)(lr + j); z += v.x * w2r[j] + v.y * w2r[j + 1] + v.z * w2r[j + 2] + v.w * w2r[j + 3]; } \
            const float ls = fminf(z, 0.f) - __logf(1.f + __expf(-fabsf(z))); \
            run += ls * (1.f / 16.f); bc[i] = run; } \
        SEG[seg * 128 + d] = run; \
        __syncthreads(); \
        float off = 0.f, tot = 0.f; \
        _Pragma("unroll") for (int s = 0; s < 4; ++s) { const float v = SEG[s * 128 + d]; tot += v; if (s < seg) off += v; }

__device__ __forceinline__ void gla_m1(unsigned char* lds, const bf16_t* __restrict__ P, const bf16_t* __restrict__ Vt, float* __restrict__ KV, float* __restrict__ DECb,
                                       const float* __restrict__ w2, const float* __restrict__ b2, int u) {
    int tid_ = threadIdx.x; asm volatile("" : "+v"(tid_));
    const int tid = tid_, lane = tid & 63, w = __builtin_amdgcn_readfirstlane(tid >> 6), l31 = lane & 31, hi = lane >> 5;
    const int bh = u / NCHUNK, n = u - bh * NCHUNK, b = bh >> 2, h = bh & 3;
    const int d = tid & 127, seg = tid >> 7;
    float w2r[16];
#pragma unroll
    for (int j = 0; j < 16; ++j) w2r[j] = w2[(size_t)j * 512 + h * 128 + d];
    const float b2r = b2[h * 128 + d];
    float* LR = (float*)(lds + GL_LR); float* SEG = (float*)(lds + GL_SEG);
    const int tok8 = tid >> 3, part = tid & 7;
    const size_t R0 = (size_t)b * LP + 64 * n;
    const unsigned lrw = *(const unsigned*)(P + (R0 + tok8) * INP + 6144 + 2 * part);
    { const bf16_t* kp = P + (R0 + (tid >> 4)) * INP + 3584 + h * 128 + (tid & 15) * 8;
      const u32x4 k0 = *(const u32x4*)kp, k1 = *(const u32x4*)(kp + (size_t)32 * INP);
      unsigned char* rk = lds + GL_RAWK + (tid >> 4) * 256 + (tid & 15) * 16;
      *(u32x4*)rk = k0; *(u32x4*)(rk + 32 * 256) = k1; }
    u32x4 vt[4];
    { const bf16_t* vp = Vt + ((size_t)b * 1024 + h * 256 + (tid >> 3)) * LP + 64 * n + (tid & 7) * 8;
#pragma unroll
      for (int i = 0; i < 4; ++i) vt[i] = *(const u32x4*)(vp + (size_t)(64 * i) * LP); }
    LR[tok8 * 16 + 2 * part] = bflo(lrw); LR[tok8 * 16 + 2 * part + 1] = bfhi(lrw);
    __syncthreads();
    GL_GATE()
    if (seg == 0) DECb[(size_t)u * 128 + d] = __expf(tot);
    {
        unsigned ko[8];
#pragma unroll
        for (int i = 0; i < 16; i += 2) {
            const float b0 = bc[i] + off, b1 = bc[i + 1] + off;
            const bf16_t* rk = (const bf16_t*)(lds + GL_RAWK + (16 * seg + i) * 256) + d;
            ko[i >> 1] = pack2(bf2f(rk[0]) * __expf(tot - b0), bf2f(rk[128]) * __expf(tot - b1));
        }
        unsigned char* kod = lds + GL_KOUT + d * GL_TSTR + seg * 32;
        *(u32x4*)kod = (u32x4){ko[0], ko[1], ko[2], ko[3]}; *(u32x4*)(kod + 16) = (u32x4){ko[4], ko[5], ko[6], ko[7]};
#pragma unroll
        for (int i = 0; i < 4; ++i) *(u32x4*)(lds + GL_VT + ((tid >> 3) + 64 * i) * GL_TSTR + (tid & 7) * 16) = vt[i];
    }
    __syncthreads();
    const unsigned char* va = lds + GL_VT + (32 * w + l31) * GL_TSTR + hi * 16;
    const bf16x8 v0 = *(const bf16x8*)(va), v1 = *(const bf16x8*)(va + 32), v2 = *(const bf16x8*)(va + 64), v3 = *(const bf16x8*)(va + 96);
    float* kvo = KV + (size_t)u * 32768 + (size_t)(w * 4) * 1024 + lane;
#pragma unroll
    for (int kb = 0; kb < 4; ++kb) {
        f32x16 S;
#pragma unroll
        for (int r = 0; r < 16; ++r) S[r] = 0.f;
        const unsigned char* ko = lds + GL_KOUT + (32 * kb + l31) * GL_TSTR + hi * 16;
        S = MFMA32(*(const bf16x8*)(ko), v0, S); S = MFMA32(*(const bf16x8*)(ko + 32), v1, S);
        S = MFMA32(*(const bf16x8*)(ko + 64), v2, S); S = MFMA32(*(const bf16x8*)(ko + 96), v3, S);
#pragma unroll
        for (int r = 0; r < 16; ++r) kvo[(kb * 16 + r) * 64] = S[r];
    }
}

__device__ __forceinline__ void gla_scan(const float* __restrict__ KV, const float* __restrict__ DECb, u32x4* __restrict__ SP, int g) {
    const int lane = g & 63, s = (g >> 6) & 1, kb = (g >> 7) & 3, w = (g >> 9) & 7, bh = g >> 12, hi = lane >> 5;
    const float* kv = KV + (size_t)(bh * NCHUNK) * 32768 + (size_t)((w * 4 + kb) * 16 + 8 * s) * 64 + lane;
    const float* dc = DECb + (size_t)(bh * NCHUNK) * 128 + 32 * kb + 16 * s + 4 * hi;
    u32x4* sp = SP + (size_t)(bh * NCHUNK) * 4096 + ((w * 4 + kb) * 2 + s) * 64 + lane;
    float S[8];
#pragma unroll
    for (int j = 0; j < 8; ++j) S[j] = 0.f;
#pragma unroll 3
    for (int n = 0; n < NCHUNK; ++n) {
        float t[8];
#pragma unroll
        for (int j = 0; j < 8; ++j) t[j] = kv[(size_t)n * 32768 + j * 64];
        const f32x4 d0 = *(const f32x4*)(dc + (size_t)n * 128), d1 = *(const f32x4*)(dc + (size_t)n * 128 + 8);
        sp[(size_t)n * 4096] = (u32x4){pack2(S[0], S[1]), pack2(S[2], S[3]), pack2(S[4], S[5]), pack2(S[6], S[7])};
        S[0] = S[0] * d0.x + t[0]; S[1] = S[1] * d0.y + t[1]; S[2] = S[2] * d0.z + t[2]; S[3] = S[3] * d0.w + t[3];
        S[4] = S[4] * d1.x + t[4]; S[5] = S[5] * d1.y + t[5]; S[6] = S[6] * d1.z + t[6]; S[7] = S[7] * d1.w + t[7];
    }
}

__device__ __forceinline__ void gla_m3(unsigned char* lds, const bf16_t* __restrict__ P, const bf16_t* __restrict__ Vt, const u32x4* __restrict__ SP, bf16_t* __restrict__ OC,
                                       const float* __restrict__ w2, const float* __restrict__ b2, const float* __restrict__ ng, int u) {
    int tid_ = threadIdx.x; asm volatile("" : "+v"(tid_));
    const int tid = tid_, lane = tid & 63, w = __builtin_amdgcn_readfirstlane(tid >> 6), l31 = lane & 31, hi = lane >> 5;
    const int bh = u / NCHUNK, n = u - bh * NCHUNK, b = bh >> 2, h = bh & 3;
    const int d = tid & 127, seg = tid >> 7;
    float w2r[16];
#pragma unroll
    for (int j = 0; j < 16; ++j) w2r[j] = w2[(size_t)j * 512 + h * 128 + d];
    const float b2r = b2[h * 128 + d];
    float* LR = (float*)(lds + GL_LR); float* SEG = (float*)(lds + GL_SEG); float* NG = (float*)(lds + GL_NG);
    if (tid < 256) NG[tid] = ng[tid];
    const int dpos = swap23(d);
    const int tok8 = tid >> 3, part = tid & 7;
    const size_t R0 = (size_t)b * LP + 64 * n;
    const unsigned lrw = *(const unsigned*)(P + (R0 + tok8) * INP + 6144 + 2 * part);
    { const bf16_t* qp = P + (R0 + (tid >> 4)) * INP + 3072 + h * 128 + (tid & 15) * 8;
      const u32x4 q0 = *(const u32x4*)qp, q1 = *(const u32x4*)(qp + (size_t)32 * INP), k0 = *(const u32x4*)(qp + 512), k1 = *(const u32x4*)(qp + (size_t)32 * INP + 512);
      unsigned char* rq = lds + GL_RAWQ + (tid >> 4) * 256 + (tid & 15) * 16;
      *(u32x4*)rq = q0; *(u32x4*)(rq + 32 * 256) = q1; *(u32x4*)(rq + 16384) = k0; *(u32x4*)(rq + 16384 + 32 * 256) = k1; }
    u32x4 vt[4];
    { const bf16_t* vp = Vt + ((size_t)b * 1024 + h * 256 + (tid >> 3)) * LP + 64 * n + (tid & 7) * 8;
#pragma unroll
      for (int i = 0; i < 4; ++i) vt[i] = *(const u32x4*)(vp + (size_t)(64 * i) * LP); }
    LR[tok8 * 16 + 2 * part] = bflo(lrw); LR[tok8 * 16 + 2 * part + 1] = bfhi(lrw);
    __syncthreads();
    GL_GATE()
    {
#pragma unroll
        for (int i = 0; i < 16; i += 2) {
            const float b0 = bc[i] + off, b1 = bc[i + 1] + off;
            const bf16_t* rq = (const bf16_t*)(lds + GL_RAWQ + (16 * seg + i) * 256) + d;
            const float q0 = bf2f(rq[0]) * __expf(b0) * 0.08838834764831845f, q1 = bf2f(rq[128]) * __expf(b1) * 0.08838834764831845f;
            const float k0 = bf2f(rq[8192]), k1 = bf2f(rq[8192 + 128]);
            const unsigned qq = pack2(q0, q1), kk = pack2(k0 * __expf(-b0), k1 * __expf(-b1));
            bf16_t* qd = (bf16_t*)(lds + GL_QIN + (16 * seg + i) * GL_QSTR) + dpos; bf16_t* kd = (bf16_t*)(lds + GL_KIN + (16 * seg + i) * GL_QSTR) + dpos;
            qd[0] = (bf16_t)(qq & 0xffffu); qd[GL_QSTR / 2] = (bf16_t)(qq >> 16); kd[0] = (bf16_t)(kk & 0xffffu); kd[GL_QSTR / 2] = (bf16_t)(kk >> 16);
        }
#pragma unroll
        for (int i = 0; i < 4; ++i) *(u32x4*)(lds + GL_VT + ((tid >> 3) + 64 * i) * GL_TSTR + (tid & 7) * 16) = vt[i];
    }
    u32x4 sp[8];
    { const u32x4* spp = SP + (size_t)u * 4096 + (size_t)(w * 8) * 64 + lane;
#pragma unroll
      for (int i = 0; i < 8; ++i) sp[i] = spp[i * 64]; }
    __syncthreads();
    f32x16 X00, X01, X11;
#pragma unroll
    for (int r = 0; r < 16; ++r) { X00[r] = 0.f; X01[r] = 0.f; X11[r] = 0.f; }
    {
        const unsigned char* ka = lds + GL_KIN + swap23(l31) * GL_QSTR + hi * 16;
        const unsigned char* qa = lds + GL_QIN + l31 * GL_QSTR + hi * 16;
#pragma unroll 2
        for (int ks = 0; ks < 8; ++ks) {
            const bf16x8 k0 = *(const bf16x8*)(ka + ks * 32), k1 = *(const bf16x8*)(ka + 32 * GL_QSTR + ks * 32);
            const bf16x8 q0 = *(const bf16x8*)(qa + ks * 32), q1 = *(const bf16x8*)(qa + 32 * GL_QSTR + ks * 32);
            X00 = MFMA32(k0, q0, X00); X01 = MFMA32(k0, q1, X01); X11 = MFMA32(k1, q1, X11);
        }
#pragma unroll
        for (int r = 0; r < 16; ++r) { const int j = 16 * (r >> 3) + 8 * hi + (r & 7); if (j > l31) { X00[r] = 0.f; X11[r] = 0.f; } }
    }
    f32x16 Oa, Ob; u32x4 go[4];
#pragma unroll
    for (int r = 0; r < 16; ++r) { Oa[r] = 0.f; Ob[r] = 0.f; }
    {
        const unsigned char* va = lds + GL_VT + (32 * w + l31) * GL_TSTR + hi * 16;
        const bf16x8 v0 = *(const bf16x8*)(va), v1 = *(const bf16x8*)(va + 32), v2 = *(const bf16x8*)(va + 64), v3 = *(const bf16x8*)(va + 96);
        Oa = MFMA32(pack8(X00, 0), v0, Oa); Oa = MFMA32(pack8(X00, 1), v1, Oa);
        Ob = MFMA32(pack8(X01, 0), v0, Ob); Ob = MFMA32(pack8(X01, 1), v1, Ob);
        Ob = MFMA32(pack8(X11, 0), v2, Ob); Ob = MFMA32(pack8(X11, 1), v3, Ob);
        { const bf16_t* gp = P + (R0 + tok8) * INP + 5120 + h * 256 + 32 * part;
#pragma unroll
          for (int i = 0; i < 4; ++i) go[i] = *(const u32x4*)(gp + 8 * i); }
        const unsigned char* qa = lds + GL_QIN + l31 * GL_QSTR + hi * 16;
#pragma unroll
        for (int kb = 0; kb < 4; ++kb)
#pragma unroll
            for (int s = 0; s < 2; ++s) {
                const bf16x8 sb = __builtin_bit_cast(bf16x8, sp[kb * 2 + s]);
                const bf16x8 q0 = *(const bf16x8*)(qa + kb * 64 + s * 32), q1 = *(const bf16x8*)(qa + 32 * GL_QSTR + kb * 64 + s * 32);
                Oa = MFMA32(q0, sb, Oa); Ob = MFMA32(q1, sb, Ob);
            }
    }
    __syncthreads();
    {
        float* ost = (float*)lds;
#pragma unroll
        for (int r = 0; r < 16; ++r) { ost[crow(r, hi) * GL_OSTR + 32 * w + l31] = Oa[r]; ost[(32 + crow(r, hi)) * GL_OSTR + 32 * w + l31] = Ob[r]; }
    }
    __syncthreads();
    {
        const float* orow = (const float*)lds + tok8 * GL_OSTR + 32 * part;
        f32x4 ov[8]; float ss = 0.f;
#pragma unroll
        for (int i = 0; i < 8; ++i) { ov[i] = *(const f32x4*)(orow + 4 * i); ss += (ov[i].x * ov[i].x + ov[i].y * ov[i].y) + (ov[i].z * ov[i].z + ov[i].w * ov[i].w); }
        ss += __shfl_xor(ss, 1); ss += __shfl_xor(ss, 2); ss += __shfl_xor(ss, 4);
        const float rs = rsqrtf(ss * (1.f / 256.f) + EPS);
        bf16_t* od = OC + (R0 + tok8) * DM + 1024 + h * 256 + 32 * part;
#pragma unroll
        for (int i = 0; i < 4; ++i) {
            unsigned ow[4];
#pragma unroll
            for (int q = 0; q < 4; ++q) {
                const int e = 8 * i + 2 * q; const f32x4 o4 = ov[e >> 2]; const float o0 = (e & 2) ? o4.z : o4.x, o1 = (e & 2) ? o4.w : o4.y;
                const float g0 = bflo(go[i][q]), g1 = bfhi(go[i][q]);
                ow[q] = pack2(o0 * rs * NG[32 * part + e] * (g0 / (1.f + __expf(-g0))), o1 * rs * NG[32 * part + e + 1] * (g1 / (1.f + __expf(-g1))));
            }
            *(u32x4*)(od + 8 * i) = (u32x4){ow[0], ow[1], ow[2], ow[3]};
        }
    }
}

constexpr int PTAB = 134144;
#ifndef RP_PRO
#define RP_PRO 1
#endif
#ifndef RP_MIX
#define RP_MIX 1
#endif
#ifndef RP_G3
#define RP_G3 1
#endif
#ifndef RP_G4
#define RP_G4 1
#endif
#ifndef RP_GLA
#define RP_GLA 1
#endif
#ifndef RP_ATT
#define RP_ATT 1
#endif
#ifndef RP_M1
#define RP_M1 1
#endif
#ifndef RP_SCAN
#define RP_SCAN 1
#endif
#ifndef RP_M3
#define RP_M3 1
#endif
#ifndef RP_BAR
#define RP_BAR 1
#endif
#ifndef RP_G1
#define RP_G1 1
#endif
#ifndef RP_G2
#define RP_G2 1
#endif
#ifndef RP_CONV
#define RP_CONV 1
#endif
enum { T_X = 0, T_META, T_PRE_MIX_G, T_W_IN, T_DA_LAMBDA, T_DA_SUBLN_G, T_GATE_W2, T_GATE_B, T_GLA_NORM_G, T_W_OUT, T_POST_MIX_G, T_PRE_FFN_G, T_W_UP, T_CONV_W, T_CONV_B, T_W_DOWN, T_POST_FFN_G, T_OUT, T_WS, T_N };
__device__ __forceinline__ unsigned long long ldp_(const unsigned char* lds, int i) {
    const unsigned long long v = ((const volatile unsigned long long*)(lds + PTAB))[i];
    const unsigned lo = __builtin_amdgcn_readfirstlane((unsigned)v), hi = __builtin_amdgcn_readfirstlane((unsigned)(v >> 32));
    return ((unsigned long long)hi << 32) | lo;
}
#define LDF(i) ((const float*)ldp_(lds, (i)))
#define LDWS() ((unsigned char*)ldp_(lds, T_WS))
__global__ void __launch_bounds__(NTHR) hymba_fwd(Params p) {
    extern __shared__ __attribute__((aligned(16))) unsigned char lds[];
    cg::grid_group grid = cg::this_grid();
    if (threadIdx.x == 0) {
        unsigned long long* tab = (unsigned long long*)(lds + PTAB);
        tab[T_X] = (unsigned long long)p.x; tab[T_META] = (unsigned long long)p.meta; tab[T_PRE_MIX_G] = (unsigned long long)p.pre_mix_g; tab[T_W_IN] = (unsigned long long)p.w_in;
        tab[T_DA_LAMBDA] = (unsigned long long)p.da_lambda; tab[T_DA_SUBLN_G] = (unsigned long long)p.da_subln_g; tab[T_GATE_W2] = (unsigned long long)p.gate_w2; tab[T_GATE_B] = (unsigned long long)p.gate_b;
        tab[T_GLA_NORM_G] = (unsigned long long)p.gla_norm_g; tab[T_W_OUT] = (unsigned long long)p.w_out; tab[T_POST_MIX_G] = (unsigned long long)p.post_mix_g; tab[T_PRE_FFN_G] = (unsigned long long)p.pre_ffn_g;
        tab[T_W_UP] = (unsigned long long)p.w_up; tab[T_CONV_W] = (unsigned long long)p.conv_w; tab[T_CONV_B] = (unsigned long long)p.conv_b; tab[T_W_DOWN] = (unsigned long long)p.w_down;
        tab[T_POST_FFN_G] = (unsigned long long)p.post_ffn_g; tab[T_OUT] = (unsigned long long)p.out; tab[T_WS] = (unsigned long long)p.ws;
    }
    if (threadIdx.x == 0) { volatile LAS unsigned* st = (volatile LAS unsigned*)((LAS unsigned char*)lds + PTAB + 256); st[0] = 0u; st[1] = 0u; }
    __syncthreads();
    if ((p.ph_hi - p.ph_lo) > 1) (void)xcd_barrier_post((unsigned*)(p.ws + WS_CTL), (volatile LAS unsigned*)((LAS unsigned char*)lds + PTAB + 256));
    const int lo = p.ph_lo, hi_ = p.ph_hi; const bool multi = (hi_ - lo) > 1;
    int ph = 0;
#define IN_PH() (ph >= lo && ph < hi_)
#define SEAM() do { ++ph; if (multi) { if (ph == 1) grid.sync(); else { XcdBarrier xb_; xb_.bar = (unsigned*)(LDWS() + WS_CTL); xb_.x = xb_xcc_id(); xb_.st = (volatile LAS unsigned*)((LAS unsigned char*)lds + PTAB + 256); for (int r3 = 0; r3 < RP_BAR; ++r3) xcd_barrier(xb_); } } } while (0)
#define PH_VARS() int tid_ = threadIdx.x; asm volatile("" : "+v"(tid_)); int bx = blockIdx.x; asm volatile("" : "+s"(bx)); const int G = gridDim.x; \
    const int tid = tid_, lane = tid & 63, wave = __builtin_amdgcn_readfirstlane(tid >> 6); const int gw = bx * NWAVE + wave, ngw = G * NWAVE; \
    unsigned char* ws = LDWS(); LAS unsigned char* ldsa = (LAS unsigned char*)lds; (void)lane; (void)gw; (void)ngw; (void)ldsa; (void)ws

#ifndef NO_PRO
    for (int rp = 0; rp < RP_PRO; ++rp) if (IN_PH()) {
        PH_VARS();
        LAS float* scr = (LAS float*)(ldsa + wave * 16640);
        constexpr int NB_IN = INP / 64, NB_D = DM / 64, NB_UP = DFF2 / 64;
        constexpr int I_IN = (DM / 64) * NB_IN, I_OUT = (DM / 64) * NB_D, I_UP = (DM / 64) * NB_UP, I_DN = (DFF / 64) * NB_D, I_L = I_IN + I_OUT + I_UP + I_DN;
        const float* w_in = LDF(T_W_IN); const float* w_out = LDF(T_W_OUT); const float* w_up = LDF(T_W_UP); const float* w_dn = LDF(T_W_DOWN);
#define TDEC(ti, it_) do { const int l_ = (it_) / I_L; int r_ = (it_) - l_ * I_L; int nblk_; \
            if (r_ < I_IN) { ti.W = w_in + (size_t)l_ * DM * INC; ti.WT = (bf16_t*)(ws + WS_WIN) + (size_t)l_ * INP * DM; ti.K = DM; ti.Nsrc = INC; nblk_ = NB_IN; } \
            else if ((r_ -= I_IN) < I_OUT) { ti.W = w_out + (size_t)l_ * DM * DM; ti.WT = (bf16_t*)(ws + WS_WOUT) + (size_t)l_ * DM * DM; ti.K = DM; ti.Nsrc = DM; nblk_ = NB_D; } \
            else if ((r_ -= I_OUT) < I_UP) { ti.W = w_up + (size_t)l_ * DM * DFF2; ti.WT = (bf16_t*)(ws + WS_WUP) + (size_t)l_ * DFF2 * DM; ti.K = DM; ti.Nsrc = DFF2; nblk_ = NB_UP; } \
            else { r_ -= I_UP; ti.W = w_dn + (size_t)l_ * DFF * DM; ti.WT = (bf16_t*)(ws + WS_WDN) + (size_t)l_ * DM * DFF; ti.K = DFF; ti.Nsrc = DM; nblk_ = NB_D; } \
            const int kb_ = r_ / nblk_; ti.k0 = 64 * kb_; ti.n0 = 64 * (r_ - kb_ * nblk_); } while (0)
        {
            constexpr int NIT = DEPTH * I_L;
            float ra[64], rb[64]; TItem ta, tb;
            int it = gw;
            if (it < NIT) {
                TDEC(ta, it); titem_load(ta, ra, lane);
                for (;;) {
                    const int itb = it + ngw; const bool vb = itb < NIT;
                    if (vb) { TDEC(tb, itb); titem_load(tb, rb, lane); }
                    titem_store(ta, ra, scr, lane);
                    if (!vb) break;
                    it = itb + ngw; const bool va = it < NIT;
                    if (va) { TDEC(ta, it); titem_load(ta, ra, lane); }
                    titem_store(tb, rb, scr, lane);
                    if (!va) break;
                }
            }
        }
#undef TDEC
        row_phase<0>(LDF(T_X), LDF(T_META), nullptr, (float*)(ws + WS_X), (float*)(ws + WS_X), nullptr, nullptr, 0, (bf16_t*)(ws + WS_H), nullptr, LDF(T_PRE_MIX_G), gw, ngw, lane);
    }
#endif
    SEAM();

    for (int l = 0; l < DEPTH; ++l) {
        for (int rp = 0; rp < RP_G1; ++rp) if (IN_PH()) {
            PH_VARS();
            pg8::Gemm g{(bf16_t*)(ws + WS_H), (bf16_t*)(ws + WS_WIN) + (size_t)l * INP * DM, MP, INP, DM}; pg8::StaticOrder S; S.init(MP, INP, G, bx);
            pg8::EpiIn E{(bf16_t*)(ws + WS_P), INP, (bf16_t*)(ws + WS_VTA), (bf16_t*)(ws + WS_VTB), LP, 0.125f * 1.4426950408889634f};
#ifndef NO_G1
            pg8::gemm_phase<pg8::EpiIn, pg8::StaticOrder, true, true>(ldsa, g, S, E);
#endif
        }
        SEAM();
        for (int sub = 0; sub < 3; ++sub) {
            for (int rp = 0; rp < RP_MIX; ++rp) if (IN_PH()) {
                PH_VARS();
                const bf16_t* P = (const bf16_t*)(ws + WS_P); bf16_t* OC = (bf16_t*)(ws + WS_OC);
                if (sub == 1) {
                    for (int r2 = 0; r2 < RP_SCAN; ++r2) if (tid < 256 && bx * 256 + tid < 65536) gla_scan((const float*)(ws + WS_KV), (const float*)(ws + WS_DEC), (u32x4*)(ws + WS_SP), bx * 256 + tid);
                } else {
                    if (sub == 0) { for (int r2 = 0; r2 < RP_M1; ++r2) for (int u = G - 1 - bx; u < NGU; u += G) gla_m1(lds, P, (const bf16_t*)(ws + WS_VTB), (float*)(ws + WS_KV), (float*)(ws + WS_DEC), LDF(T_GATE_W2) + (size_t)l * 16 * 512, LDF(T_GATE_B) + (size_t)l * 512, u); }
                    else { for (int r2 = 0; r2 < RP_M3; ++r2) for (int u = bx; u < NGU; u += G) gla_m3(lds, P, (const bf16_t*)(ws + WS_VTB), (const u32x4*)(ws + WS_SP), OC, LDF(T_GATE_W2) + (size_t)l * 16 * 512, LDF(T_GATE_B) + (size_t)l * 512, LDF(T_GLA_NORM_G) + (size_t)l * 256, u); }
                    __syncthreads();
                    float* subg = (float*)(lds + 80000); float* lamw = subg + 128;
                    const float lam_init = 0.8f - 0.6f * __expf(-0.3f * (float)l);
                    if (tid < 128) subg[tid] = LDF(T_DA_SUBLN_G)[(size_t)l * 128 + tid];
                    if (wave == 0) { const float* lv = LDF(T_DA_LAMBDA) + (size_t)l * 256; const float a = wave_sum(lv[lane] * lv[64 + lane]), c2 = wave_sum(lv[128 + lane] * lv[192 + lane]);
                        if (lane == 0) lamw[0] = __expf(a) - __expf(c2) + lam_init; }
                    __syncthreads();
                    const float lam = lamw[0];
                    for (int ra = 0; ra < RP_ATT; ++ra) for (int k = (sub == 0 ? 0 : 1); k * G < 544 && (sub != 0 || k < 1); ++k) {
                        const int j = k * G + ((k & 1) ? (G - 1 - bx) : bx);
                        if (j < 544) attn_unit(lds, P, (const bf16_t*)(ws + WS_VTA), OC, subg, (j & 31) >> 3, j & 7, 16 - (j >> 5), lam, 1.f - lam_init);
                    }
                }
            }
            SEAM();
        }
        for (int rp = 0; rp < RP_G2; ++rp) if (IN_PH()) {
            PH_VARS();
            { pg8::Gemm g{(bf16_t*)(ws + WS_OC), (bf16_t*)(ws + WS_WOUT) + (size_t)l * DM * DM, MP, DM, DM, DM}; pg8::FullOrder32 S{G, bx};
              pg8::EpiF32 E{(float*)(ws + WS_Y), DM};
              pg8::gemm_phase<pg8::EpiF32, pg8::FullOrder32, true, true>(ldsa, g, S, E); }
            __builtin_amdgcn_sched_barrier(0); asm volatile("" : "+s"(bx) :: "memory"); __builtin_amdgcn_sched_barrier(0);
            { int kp = 256; asm volatile("" : "+s"(kp)); pg8::Gemm g{(bf16_t*)(ws + WS_OC), (bf16_t*)(ws + WS_WOUT) + (size_t)l * DM * DM, MP, DM, kp, DM}; pg8::SplitOrder32 S{G, bx, 8, kp};
              pg8::EpiPart E{(float*)(ws + WS_PART), DM, kp};
              pg8::gemm_phase<pg8::EpiPart, pg8::SplitOrder32, true, true>(ldsa, g, S, E); }
        }
        SEAM();
#ifndef NO_ROW
#ifdef RP_ROW
        if (IN_PH()) { PH_VARS(); row_phase<1>(nullptr, nullptr, nullptr, (float*)(ws + WS_X), (float*)(ws + WS_KV), (const float*)(ws + WS_Y), (const float*)(ws + WS_PART), 8, (bf16_t*)(ws + WS_SP), LDF(T_POST_MIX_G) + (size_t)l * DM, LDF(T_PRE_FFN_G) + (size_t)l * DM, gw, ngw, lane); }
#endif
        if (IN_PH()) { PH_VARS(); row_phase<1>(nullptr, nullptr, nullptr, (float*)(ws + WS_X), (float*)(ws + WS_X), (const float*)(ws + WS_Y), (const float*)(ws + WS_PART), 8, (bf16_t*)(ws + WS_H), LDF(T_POST_MIX_G) + (size_t)l * DM, LDF(T_PRE_FFN_G) + (size_t)l * DM, gw, ngw, lane); }
#endif
        SEAM();
        for (int rp = 0; rp < RP_G3; ++rp) if (IN_PH()) {
            PH_VARS();
            pg8::Gemm g{(bf16_t*)(ws + WS_H), (bf16_t*)(ws + WS_WUP) + (size_t)l * DFF2 * DM, MP, DFF2, DM}; pg8::StaticOrder S; S.init(MP, DFF2, G, bx);
            pg8::EpiB16 E{(bf16_t*)(ws + WS_U), DFF2};
#ifndef NO_G3
            pg8::gemm_phase<pg8::EpiB16, pg8::StaticOrder, true, true>(ldsa, g, S, E);
#endif
        }
        SEAM();
#ifndef NO_CONV
        for (int rp = 0; rp < RP_CONV; ++rp) if (IN_PH()) { PH_VARS(); conv_phase((const bf16_t*)(ws + WS_U), (bf16_t*)(ws + WS_G), LDF(T_CONV_W) + (size_t)l * 3 * DFF2, LDF(T_CONV_B) + (size_t)l * DFF2, bx * NTHR + tid, G * NTHR); }
#endif
        SEAM();
        for (int rp = 0; rp < RP_G4; ++rp) if (IN_PH()) {
            PH_VARS();
            { pg8::Gemm g{(bf16_t*)(ws + WS_G), (bf16_t*)(ws + WS_WDN) + (size_t)l * DM * DFF, MP, DM, DFF, DFF}; pg8::FullOrder32 S{G, bx};
              pg8::EpiF32 E{(float*)(ws + WS_Y), DM};
              pg8::gemm_phase<pg8::EpiF32, pg8::FullOrder32, true, true>(ldsa, g, S, E); }
            __builtin_amdgcn_sched_barrier(0); asm volatile("" : "+s"(bx) :: "memory"); __builtin_amdgcn_sched_barrier(0);
            { int kp = 256; asm volatile("" : "+s"(kp)); pg8::Gemm g{(bf16_t*)(ws + WS_G), (bf16_t*)(ws + WS_WDN) + (size_t)l * DM * DFF, MP, DM, kp, DFF}; pg8::SplitOrder32 S{G, bx, 22, kp};
              pg8::EpiPart E{(float*)(ws + WS_PART), DM, kp};
              pg8::gemm_phase<pg8::EpiPart, pg8::SplitOrder32, true, true>(ldsa, g, S, E); }
        }
        SEAM();
#ifndef NO_ROW
        if (IN_PH()) {
            PH_VARS();
            if (l + 1 < DEPTH) row_phase<1>(nullptr, nullptr, nullptr, (float*)(ws + WS_X), (float*)(ws + WS_X), (const float*)(ws + WS_Y), (const float*)(ws + WS_PART), 22, (bf16_t*)(ws + WS_H), LDF(T_POST_FFN_G) + (size_t)l * DM, LDF(T_PRE_MIX_G) + (size_t)(l + 1) * DM, gw, ngw, lane);
            else row_phase<2>(nullptr, nullptr, (float*)ldp_(lds, T_OUT), (float*)(ws + WS_X), (float*)(ws + WS_X), (const float*)(ws + WS_Y), (const float*)(ws + WS_PART), 22, nullptr, LDF(T_POST_FFN_G) + (size_t)l * DM, nullptr, gw, ngw, lane);
        }
#endif
        if (l + 1 < DEPTH) SEAM(); else ++ph;
    }
#undef IN_PH
#undef SEAM
}
constexpr int N_PHASES = 1 + 10 * DEPTH;

#ifndef MULTI_LAUNCH
#define MULTI_LAUNCH 0
#endif
extern "C" void kernel_launch(void* const* d_in, const int* in_sizes, int n_in, void* d_out, int out_size, void* d_ws, size_t ws_size, hipStream_t stream) {
    static int grid = 0;
    if (grid == 0) {
        if (n_in != 17 || ws_size < WS_END) { fprintf(stderr, "kernel_launch: need 17 inputs and %zu bytes of workspace (got %d, %zu)\n", (size_t)WS_END, n_in, ws_size); grid = -1; return; }
        int dev = 0, cus = 0, per_cu = 0;
        hipGetDevice(&dev); hipDeviceGetAttribute(&cus, hipDeviceAttributeMultiprocessorCount, dev);
        if (hipFuncSetAttribute((const void*)hymba_fwd, hipFuncAttributeMaxDynamicSharedMemorySize, LDS_BYTES) != hipSuccess) { fprintf(stderr, "kernel_launch: hipFuncSetAttribute failed\n"); grid = -1; return; }
        if (hipOccupancyMaxActiveBlocksPerMultiprocessor(&per_cu, (const void*)hymba_fwd, NTHR, LDS_BYTES) != hipSuccess || per_cu < 1) { fprintf(stderr, "kernel_launch: occupancy query gave %d\n", per_cu); per_cu = 1; }
        (void)hipGetLastError();
        grid = cus * (per_cu > 1 ? 1 : per_cu);
        if (grid * 256 < 65536) { fprintf(stderr, "kernel_launch: grid %d too small for the GLA scan mapping\n", grid); grid = -1; return; }
    }
    if (grid < 0) return;
    Params p{};
    const float** pp = (const float**)&p;
    for (int i = 0; i < 17; ++i) pp[i] = (const float*)d_in[i];
    p.out = (float*)d_out; p.ws = (unsigned char*)d_ws;
#if MULTI_LAUNCH
    for (int ph = 0; ph < N_PHASES; ++ph) { p.ph_lo = ph; p.ph_hi = ph + 1; hipLaunchKernelGGL(hymba_fwd, dim3(grid), dim3(NTHR), LDS_BYTES, stream, p); }
#else
    p.ph_lo = 0; p.ph_hi = N_PHASES;
    if (hipMemsetAsync((unsigned char*)d_ws + WS_CTL, 0, CTL_BYTES, stream) != hipSuccess) { fprintf(stderr, "kernel_launch: memset of the barrier words failed\n"); return; }
    void* args[] = {&p};
    hipError_t e = hipLaunchCooperativeKernel((const void*)hymba_fwd, dim3(grid), dim3(NTHR), args, LDS_BYTES, stream);
    if (e != hipSuccess) fprintf(stderr, "kernel_launch: cooperative launch failed: %s (grid %d)\n", hipGetErrorString(e), grid);
#endif
}
```

```cpp
#include <hip/hip_runtime.h>
#include <hip/hip_cooperative_groups.h>
#include <cstdio>
#include <cstdint>
namespace cg = cooperative_groups;
#define MULTI_LAUNCH 0

namespace pg8 {
#define PG8_LAS __attribute__((address_space(3)))
typedef unsigned short bf16_t;
typedef short bf16x8 __attribute__((ext_vector_type(8)));
typedef float f32x4 __attribute__((ext_vector_type(4)));
typedef unsigned u32x4 __attribute__((ext_vector_type(4)));
constexpr int BM = 256, BK = 64, HALF = 128, HTB = HALF * BK * 2  , STAGE_BYTES = 8 * HTB, NXCD = 8, WGM = 8;

__host__ __device__ __forceinline__ int lds_byte(int r, int c) { const int st = (r >> 4) * 2 + (c >> 5), rr = r & 15, cc = c & 31, ob = rr * 64 + cc * 2; return st * 1024 + (ob ^ (((ob >> 9) & 1) << 5)); }
__host__ __device__ __forceinline__ void stage_rc(int b, int& R, int& C) { const int st = b / 1024, sb = b % 1024, swz = sb ^ (((sb >> 9) & 1) << 5); R = (st >> 1) * 16 + swz / 64; C = (st & 1) * 32 + (swz % 64) / 2; }
__host__ __device__ __forceinline__ int perm32(int rho) { const int n = rho >> 4, i = rho & 15; return 8 * (i >> 2) + 4 * n + (i & 3); }

struct Unit { int pm, pn, koff, arow; };
struct Gemm { const bf16_t* A; const bf16_t* Bt; int M, N, K, ld; };

struct StaticOrder {
    int nM, nN, nwg, G, c, rstride, roff;
    __host__ __device__ void init(int M, int N, int G_, int c_, int rstride_ = BM, int roff_ = 0) { nM = M / BM; nN = N / BM; nwg = nM * nN; G = G_; c = c_; rstride = rstride_; roff = roff_; }
    __host__ __device__ bool next(int i, Unit& u) const {
        const long L = (long)i * G + c; if (L >= nwg) return false;
        int wgid = (int)L; { const int q = nwg / NXCD, r = nwg % NXCD, xcd = wgid % NXCD, off = wgid / NXCD; wgid = (xcd < r ? xcd * (q + 1) : r * (q + 1) + (xcd - r) * q) + off; }
        const int nig = WGM * nN, gid = wgid / nig, fm = gid * WGM, gsz = (nM - fm) < WGM ? (nM - fm) : WGM;
        u.pm = fm + ((wgid % nig) % gsz); u.pn = (wgid % nig) / gsz; u.koff = 0; u.arow = u.pm * rstride + roff; return true;
    }
    __device__ __forceinline__ void a_ready(const Unit&) const {}
    __device__ __forceinline__ void done(const Unit&) const {}
};
__device__ __forceinline__ unsigned cvt_pk_bf16(float lo, float hi) { unsigned r; asm volatile("v_cvt_pk_bf16_f32 %0, %1, %2" : "=v"(r) : "v"(lo), "v"(hi)); return r; }

struct EpiF32 {
    static constexpr bool PERM = false, AFTER_DRAIN = false;
    float* O; int ldc;
    __device__ __forceinline__ void operator()(const f32x4 (&acc)[2][2][4][2], const Unit& u, int wr, int wc, int fr, int fq) const {
        const int row0 = u.pm * BM + wr * 64 + fr, col0 = u.pn * BM + wc * 32 + 4 * fq;
#pragma unroll
        for (int ai = 0; ai < 2; ++ai)
#pragma unroll
            for (int m = 0; m < 4; ++m) { float* rowp = O + (size_t)(row0 + ai * HALF + m * 16) * ldc + col0;
#pragma unroll
                for (int bj = 0; bj < 2; ++bj)
#pragma unroll
                    for (int n = 0; n < 2; ++n) *(f32x4*)(rowp + bj * HALF + n * 16) = acc[ai][bj][m][n]; }
    }
};
struct EpiB16 {
    static constexpr bool PERM = true, AFTER_DRAIN = false;
    bf16_t* O; int ldc;
    __device__ __forceinline__ void operator()(const f32x4 (&acc)[2][2][4][2], const Unit& u, int wr, int wc, int fr, int fq) const {
        const int row0 = u.pm * BM + wr * 64 + fr, col0 = u.pn * BM + wc * 32 + 8 * fq;
#pragma unroll
        for (int ai = 0; ai < 2; ++ai)
#pragma unroll
            for (int m = 0; m < 4; ++m) { bf16_t* rowp = O + (size_t)(row0 + ai * HALF + m * 16) * ldc + col0;
#pragma unroll
                for (int bj = 0; bj < 2; ++bj) { const f32x4 v0 = acc[ai][bj][m][0], v1 = acc[ai][bj][m][1];
                    u32x4 w; w.x = cvt_pk_bf16(v0[0], v0[1]); w.y = cvt_pk_bf16(v0[2], v0[3]); w.z = cvt_pk_bf16(v1[0], v1[1]); w.w = cvt_pk_bf16(v1[2], v1[3]);
                    *(u32x4*)(rowp + bj * HALF) = w; } }
    }
};
struct EpiIn {
    static constexpr bool PERM = true, AFTER_DRAIN = false;
    bf16_t* P; int ldc; bf16_t* VtA; bf16_t* VtB; int LPtok; float qscale;
    __device__ __forceinline__ void operator()(const f32x4 (&acc)[2][2][4][2], const Unit& u, int wr, int wc, int fr, int fq) const {
        const int row0 = u.pm * BM + wr * 64 + fr, col0 = u.pn * BM + wc * 32 + 8 * fq;
        const bool isva = (u.pn >= 8 && u.pn < 12), isvb = (u.pn >= 16 && u.pn < 20);
        if (isva || isvb) {
            bf16_t* Vt = isva ? VtA : VtB; const int cbase = col0 - (isva ? 2048 : 4096);
#pragma unroll
            for (int ai = 0; ai < 2; ++ai)
#pragma unroll
                for (int m = 0; m < 4; ++m) { const int row = row0 + ai * HALF + m * 16; const int b = row / LPtok, t = row - b * LPtok;
#pragma unroll
                    for (int bj = 0; bj < 2; ++bj) { const f32x4 v0 = acc[ai][bj][m][0], v1 = acc[ai][bj][m][1];
                        const unsigned w0 = cvt_pk_bf16(v0[0], v0[1]), w1 = cvt_pk_bf16(v0[2], v0[3]), w2 = cvt_pk_bf16(v1[0], v1[1]), w3 = cvt_pk_bf16(v1[2], v1[3]);
                        bf16_t* dst = Vt + ((size_t)b * 1024 + cbase + bj * HALF) * LPtok + t;
                        dst[0] = (bf16_t)(w0 & 0xffffu); dst[(size_t)LPtok] = (bf16_t)(w0 >> 16); dst[(size_t)2 * LPtok] = (bf16_t)(w1 & 0xffffu); dst[(size_t)3 * LPtok] = (bf16_t)(w1 >> 16);
                        dst[(size_t)4 * LPtok] = (bf16_t)(w2 & 0xffffu); dst[(size_t)5 * LPtok] = (bf16_t)(w2 >> 16); dst[(size_t)6 * LPtok] = (bf16_t)(w3 & 0xffffu); dst[(size_t)7 * LPtok] = (bf16_t)(w3 >> 16); } }
        } else {
            const float sc = (u.pn < 4) ? qscale : 1.f;
#pragma unroll
            for (int ai = 0; ai < 2; ++ai)
#pragma unroll
                for (int m = 0; m < 4; ++m) { bf16_t* rowp = P + (size_t)(row0 + ai * HALF + m * 16) * ldc + col0;
#pragma unroll
                    for (int bj = 0; bj < 2; ++bj) { const f32x4 v0 = acc[ai][bj][m][0] * sc, v1 = acc[ai][bj][m][1] * sc;
                        u32x4 w; w.x = cvt_pk_bf16(v0[0], v0[1]); w.y = cvt_pk_bf16(v0[2], v0[3]); w.z = cvt_pk_bf16(v1[0], v1[1]); w.w = cvt_pk_bf16(v1[2], v1[3]);
                        *(u32x4*)(rowp + bj * HALF) = w; } }
        }
    }
};


struct EpiPart {
    static constexpr bool PERM = false, AFTER_DRAIN = false;
    float* O; int ldc; int kpiece;
    __device__ __forceinline__ void operator()(const f32x4 (&acc)[2][2][4][2], const Unit& u, int wr, int wc, int fr, int fq) const {
        const int row0 = wr * 64 + fr, col0 = u.pn * BM + wc * 32 + 4 * fq;
        float* base = O + (size_t)(u.koff / kpiece) * 256 * ldc;
#pragma unroll
        for (int ai = 0; ai < 2; ++ai)
#pragma unroll
            for (int m = 0; m < 4; ++m) { float* rowp = base + (size_t)(row0 + ai * HALF + m * 16) * ldc + col0;
#pragma unroll
                for (int bj = 0; bj < 2; ++bj)
#pragma unroll
                    for (int n = 0; n < 2; ++n) *(f32x4*)(rowp + bj * HALF + n * 16) = acc[ai][bj][m][n]; }
    }
};
struct FullOrder32 {
    int G, c;
    __device__ bool next(int i, Unit& u) const { const int L = c + i * G; if (L >= 256) return false; const int x = L & 7, off = L >> 3; u.pm = 4 * x + (off >> 3); u.pn = off & 7; u.koff = 0; u.arow = u.pm * BM; return true; }
    __device__ __forceinline__ void a_ready(const Unit&) const {}
    __device__ __forceinline__ void done(const Unit&) const {}
};
struct SplitOrder32 {
    int G, c, nsplit, kpiece;
    __device__ bool next(int i, Unit& u) const { const int q = c + i * G; if (q >= 8 * nsplit) return false; u.pm = 32; u.pn = q & 7; u.koff = (q >> 3) * kpiece; u.arow = 32 * BM; return true; }
    __device__ __forceinline__ void a_ready(const Unit&) const {}
    __device__ __forceinline__ void done(const Unit&) const {}
};

__device__ __forceinline__ float dpp_shr1(float old, float v) { return __builtin_bit_cast(float, __builtin_amdgcn_update_dpp(__builtin_bit_cast(int, old), __builtin_bit_cast(int, v), 0x111, 0xf, 0xf, false)); }
__device__ __forceinline__ float dpp_shr2(float old, float v) { return __builtin_bit_cast(float, __builtin_amdgcn_update_dpp(__builtin_bit_cast(int, old), __builtin_bit_cast(int, v), 0x112, 0xf, 0xf, false)); }
__device__ __forceinline__ float dpp_ror1(float v) { return __builtin_bit_cast(float, __builtin_amdgcn_update_dpp(0, __builtin_bit_cast(int, v), 0x121, 0xf, 0xf, false)); }
__device__ __forceinline__ float dpp_ror2(float v) { return __builtin_bit_cast(float, __builtin_amdgcn_update_dpp(0, __builtin_bit_cast(int, v), 0x122, 0xf, 0xf, false)); }
struct EpiConvGate {
    static constexpr bool PERM = true, AFTER_DRAIN = false;
    bf16_t* Gout; const float* cw; const float* cb; PG8_LAS float* halo; int Mrows, LPtok, ldg, dff;
    __device__ __forceinline__ void operator()(const f32x4 (&acc)[2][2][4][2], const Unit& u, int wr, int wc, int fr, int fq) const {
        const int g0 = u.arow;
        const int jc = u.pn * 128 + wc * 32 + 8 * fq;
        if (fr >= 14) {
#pragma unroll
            for (int ai = 0; ai < 2; ++ai) { PG8_LAS float* hp = halo + ((((ai * 2 + wr) * 4 + wc) * 2 + (fr - 14)) * 4 + fq) * 16;
#pragma unroll
                for (int bj = 0; bj < 2; ++bj) { *(PG8_LAS f32x4*)(hp + bj * 8) = acc[ai][bj][3][0]; *(PG8_LAS f32x4*)(hp + bj * 8 + 4) = acc[ai][bj][3][1]; } }
        }
        asm volatile("s_waitcnt lgkmcnt(0)" ::: "memory"); __builtin_amdgcn_s_barrier(); asm volatile("" ::: "memory");
        float wa[3][8], wv[3][8], ba[8], bv[8];
#pragma unroll
        for (int i = 0; i < 3; ++i)
#pragma unroll
            for (int e = 0; e < 8; e += 4) { const f32x4 a = *(const f32x4*)(cw + (size_t)i * 2 * dff + jc + e), v = *(const f32x4*)(cw + (size_t)i * 2 * dff + dff + jc + e);
                wa[i][e] = a[0]; wa[i][e + 1] = a[1]; wa[i][e + 2] = a[2]; wa[i][e + 3] = a[3]; wv[i][e] = v[0]; wv[i][e + 1] = v[1]; wv[i][e + 2] = v[2]; wv[i][e + 3] = v[3]; }
#pragma unroll
        for (int e = 0; e < 8; e += 4) { const f32x4 a = *(const f32x4*)(cb + jc + e), v = *(const f32x4*)(cb + dff + jc + e);
            ba[e] = a[0]; ba[e + 1] = a[1]; ba[e + 2] = a[2]; ba[e + 3] = a[3]; bv[e] = v[0]; bv[e + 1] = v[1]; bv[e + 2] = v[2]; bv[e + 3] = v[3]; }
#pragma unroll
        for (int ai = 0; ai < 2; ++ai) {
            float h2a[8], h1a[8], h2v[8], h1v[8];
            { const int pg = ai * 2 + wr - 1;
              const PG8_LAS float* hp = halo + ((((pg < 0 ? 0 : pg) * 4 + wc) * 2) * 4 + fq) * 16;
#pragma unroll
              for (int e = 0; e < 8; e += 4) { const f32x4 x2 = *(const PG8_LAS f32x4*)(hp + e), y2 = *(const PG8_LAS f32x4*)(hp + 8 + e), x1 = *(const PG8_LAS f32x4*)(hp + 64 + e), y1 = *(const PG8_LAS f32x4*)(hp + 64 + 8 + e);
#pragma unroll
                  for (int q = 0; q < 4; ++q) { h2a[e + q] = x2[q]; h2v[e + q] = y2[q]; h1a[e + q] = x1[q]; h1v[e + q] = y1[q]; } } }
#pragma unroll
            for (int m = 0; m < 4; ++m) {
                const int i = ai * HALF + wr * 64 + m * 16 + fr, grow = g0 + i;
                const int b = grow / LPtok, t = grow - b * LPtok;
                unsigned ow[4];
#pragma unroll
                for (int e = 0; e < 8; e += 2) {
                    float gg[2];
#pragma unroll
                    for (int q = 0; q < 2; ++q) {
                        const int c = e + q; const float a0 = acc[ai][0][m][c >> 2][c & 3], v0 = acc[ai][1][m][c >> 2][c & 3];
                        float a1, a2, v1, v2;
                        if (m == 0) { a1 = dpp_shr1(h1a[c], a0); a2 = dpp_shr2(fr == 0 ? h2a[c] : h1a[c], a0); v1 = dpp_shr1(h1v[c], v0); v2 = dpp_shr2(fr == 0 ? h2v[c] : h1v[c], v0); }
                        else { const float ap = acc[ai][0][m - 1][c >> 2][c & 3], vp = acc[ai][1][m - 1][c >> 2][c & 3];
                               a1 = dpp_shr1(dpp_ror1(ap), a0); a2 = dpp_shr2(dpp_ror2(ap), a0); v1 = dpp_shr1(dpp_ror1(vp), v0); v2 = dpp_shr2(dpp_ror2(vp), v0); }
                        if (t < 1) { a1 = 0.f; v1 = 0.f; }
                        if (t < 2) { a2 = 0.f; v2 = 0.f; }
                        const float av = ba[c] + wa[0][c] * a2 + wa[1][c] * a1 + wa[2][c] * a0;
                        const float vv = bv[c] + wv[0][c] * v2 + wv[1][c] * v1 + wv[2][c] * v0;
                        gg[q] = av / (1.f + __expf(-av)) * vv;
                    }
                    ow[e >> 1] = cvt_pk_bf16(gg[0], gg[1]);
                }
                if (i >= 2 && grow < Mrows) *(u32x4*)(Gout + (size_t)grow * ldg + jc) = (u32x4){ow[0], ow[1], ow[2], ow[3]};
            }
        }
    }
};
template <class Epi, class Sched, bool ALIGN_EPI = false, bool SP2 = false>
__device__ __forceinline__ void gemm_phase(PG8_LAS unsigned char* lds, const Gemm g, const Sched& S, const Epi& E) {
    int tid_ = threadIdx.x; asm volatile("" : "+v"(tid_));
    const int tid = tid_, wid = __builtin_amdgcn_readfirstlane(tid >> 6), lane = tid & 63, wr = wid >> 2, wc = wid & 3, fr = lane & 15, fq = lane >> 4;
    const int K = g.K, nt = K / BK, LD = g.ld ? g.ld : g.K;
    unsigned voffA[2], voffB[2];
#pragma unroll
    for (int i = 0; i < 2; ++i) { int R, C; stage_rc(tid * 16 + i * 8192, R, C); const int Rb = Epi::PERM ? ((R & ~31) + perm32(R & 31)) : R;
        voffA[i] = (unsigned)(R * LD + C) * 2u; voffB[i] = (unsigned)(Rb * LD + C) * 2u; }
    const size_t kstep = (size_t)(BK * 2);
    const size_t hstep = (size_t)HALF * LD * 2;
    const size_t tstep = 2 * hstep;
    const unsigned ldsw = (unsigned)wid * 1024u;
    const int aoff = lds_byte(wr * 64 + fr, fq * 8), boff = lds_byte(wc * 32 + fr, fq * 8);
#define PG8_SA(b, h) (((b) * 2 + (h)) * HTB)
#define PG8_SB(b, h) ((4 + (b) * 2 + (h)) * HTB)
#define PG8_STAGE(bufoff, gbase, voff) do { _Pragma("unroll") for (int _i = 0; _i < 2; ++_i) \
        __builtin_amdgcn_global_load_lds((const unsigned*)((const char*)(gbase) + (voff)[_i]), (PG8_LAS unsigned*)(lds + (bufoff) + ldsw + _i * 8192), 16, 0, 0); } while (0)
#define PG8_LDA(dst, b, h) do { _Pragma("unroll") for (int m = 0; m < 4; ++m) _Pragma("unroll") for (int k = 0; k < 2; ++k) dst[m][k] = *(const PG8_LAS bf16x8*)(lds + PG8_SA(b, h) + aoff + m * 2048 + k * 1024); } while (0)
#define PG8_LDB(dst, b, h) do { _Pragma("unroll") for (int n = 0; n < 2; ++n) _Pragma("unroll") for (int k = 0; k < 2; ++k) dst[n][k] = *(const PG8_LAS bf16x8*)(lds + PG8_SB(b, h) + boff + n * 2048 + k * 1024); } while (0)
#define PG8_MMA(ai, bj, At, Bt) do { __builtin_amdgcn_s_setprio(1); _Pragma("unroll") for (int m = 0; m < 4; ++m) _Pragma("unroll") for (int n = 0; n < 2; ++n) _Pragma("unroll") for (int k = 0; k < 2; ++k) \
        acc[ai][bj][m][n] = __builtin_amdgcn_mfma_f32_16x16x32_bf16(Bt[n][k], At[m][k], acc[ai][bj][m][n], 0, 0, 0); __builtin_amdgcn_s_setprio(0); } while (0)
#define PG8_WAIT_V(n) asm volatile("s_waitcnt vmcnt(" #n ")" ::: "memory")
#define PG8_WAIT_L(n) asm volatile("s_waitcnt lgkmcnt(" #n ")" ::: "memory")
#define PG8_BAR __builtin_amdgcn_s_barrier()
#define PG8_SCHED __builtin_amdgcn_sched_barrier(0)
    Unit cur, nxt; int ui = 0;
    if (!S.next(0, cur)) return;
    f32x4 acc[2][2][4][2];
#pragma unroll
    for (int a = 0; a < 2; ++a)
#pragma unroll
        for (int b = 0; b < 2; ++b)
#pragma unroll
            for (int m = 0; m < 4; ++m)
#pragma unroll
                for (int n = 0; n < 2; ++n) acc[a][b][m][n] = (f32x4){0.f, 0.f, 0.f, 0.f};
    bf16x8 At[4][2], B0[2][2], B1[2][2];
    const char* cA = (const char*)g.A + (long)cur.arow * (long)(LD * 2) + (size_t)cur.koff * 2; const char* cB = (const char*)g.Bt + (size_t)cur.pn * tstep + (size_t)cur.koff * 2;
    S.a_ready(cur);
    if constexpr (SP2) {
        PG8_STAGE(PG8_SB(0, 0), cB, voffB); PG8_STAGE(PG8_SB(0, 1), cB + hstep, voffB); PG8_STAGE(PG8_SA(0, 0), cA, voffA); PG8_STAGE(PG8_SA(0, 1), cA + hstep, voffA);
        if (wr == 1) PG8_BAR;
        PG8_WAIT_V(2); PG8_BAR;
        PG8_STAGE(PG8_SB(1, 0), cB + kstep, voffB); PG8_STAGE(PG8_SA(1, 0), cA + kstep, voffA); PG8_STAGE(PG8_SB(1, 1), cB + hstep + kstep, voffB);
        PG8_WAIT_V(6); PG8_BAR;
    } else {
        PG8_STAGE(PG8_SB(0, 0), cB, voffB); PG8_STAGE(PG8_SA(0, 0), cA, voffA); PG8_STAGE(PG8_SB(0, 1), cB + hstep, voffB); PG8_STAGE(PG8_SA(0, 1), cA + hstep, voffA);
        if (wr == 1) PG8_BAR;
        PG8_WAIT_V(4); PG8_BAR;
        PG8_STAGE(PG8_SB(1, 0), cB + kstep, voffB); PG8_STAGE(PG8_SA(1, 0), cA + kstep, voffA); PG8_STAGE(PG8_SB(1, 1), cB + hstep + kstep, voffB);
        PG8_WAIT_V(6); PG8_BAR;
    }
    for (;;) {
        const bool has_next = S.next(ui + 1, nxt);
        const char* nA = has_next ? (const char*)g.A + (long)nxt.arow * (long)(LD * 2) + (size_t)nxt.koff * 2 : cA; const char* nB = has_next ? (const char*)g.Bt + (size_t)nxt.pn * tstep + (size_t)nxt.koff * 2 : cB;
        for (int t = 0; t < nt; t += 2) {
            const bool last = (t == nt - 2);
            const char* a1 = cA + (size_t)(t + 1) * kstep;
            const char* a2 = last ? nA : cA + (size_t)(t + 2) * kstep; const char* b2 = last ? nB : cB + (size_t)(t + 2) * kstep;
            const char* a3 = a2 + kstep; const char* b3 = b2 + kstep;
            if (last && has_next) S.a_ready(nxt);
            if constexpr (SP2) {
            PG8_LDB(B0, 0, 0); PG8_LDB(B1, 0, 1); PG8_SCHED; PG8_LDA(At, 0, 0); PG8_STAGE(PG8_SA(1, 1), a1 + hstep, voffA);
            PG8_WAIT_V(8); PG8_WAIT_L(0); PG8_BAR; PG8_MMA(0, 0, At, B0); PG8_MMA(0, 1, At, B1); PG8_BAR; PG8_SCHED;
            PG8_LDA(At, 0, 1); PG8_STAGE(PG8_SB(0, 0), b2, voffB); PG8_STAGE(PG8_SB(0, 1), b2 + hstep, voffB); PG8_STAGE(PG8_SA(0, 0), a2, voffA);
            PG8_WAIT_V(8); PG8_WAIT_L(0); PG8_BAR; PG8_MMA(1, 0, At, B0); PG8_MMA(1, 1, At, B1); PG8_BAR; PG8_SCHED;
            PG8_LDB(B0, 1, 0); PG8_LDB(B1, 1, 1); PG8_SCHED; PG8_LDA(At, 1, 0); PG8_STAGE(PG8_SA(0, 1), a2 + hstep, voffA);
            PG8_WAIT_V(8); PG8_WAIT_L(0); PG8_BAR; PG8_MMA(0, 0, At, B0); PG8_MMA(0, 1, At, B1); PG8_BAR; PG8_SCHED;
            PG8_LDA(At, 1, 1); PG8_STAGE(PG8_SB(1, 0), b3, voffB); PG8_STAGE(PG8_SB(1, 1), b3 + hstep, voffB); PG8_STAGE(PG8_SA(1, 0), a3, voffA);
            PG8_WAIT_V(8); PG8_WAIT_L(0); PG8_BAR; PG8_MMA(1, 0, At, B0); PG8_MMA(1, 1, At, B1); PG8_BAR; PG8_SCHED;
            } else {
            PG8_LDB(B0, 0, 0); PG8_SCHED; PG8_LDA(At, 0, 0); PG8_STAGE(PG8_SA(1, 1), a1 + hstep, voffA);
            PG8_WAIT_L(8); PG8_BAR; PG8_WAIT_L(0); PG8_MMA(0, 0, At, B0); PG8_BAR; PG8_SCHED;
            PG8_LDB(B1, 0, 1); PG8_STAGE(PG8_SB(0, 0), b2, voffB);
            PG8_BAR; PG8_WAIT_L(0); PG8_MMA(0, 1, At, B1); PG8_BAR;
            PG8_LDA(At, 0, 1); PG8_STAGE(PG8_SA(0, 0), a2, voffA);
            PG8_BAR; PG8_WAIT_L(0); PG8_MMA(1, 0, At, B0); PG8_BAR; PG8_SCHED;
            PG8_STAGE(PG8_SB(0, 1), b2 + hstep, voffB);
            PG8_WAIT_V(6); PG8_BAR; PG8_MMA(1, 1, At, B1); PG8_BAR;
            PG8_LDB(B0, 1, 0); PG8_SCHED; PG8_LDA(At, 1, 0); PG8_STAGE(PG8_SA(0, 1), a2 + hstep, voffA);
            PG8_WAIT_L(8); PG8_BAR; PG8_WAIT_L(0); PG8_MMA(0, 0, At, B0); PG8_BAR; PG8_SCHED;
            PG8_LDB(B1, 1, 1); PG8_STAGE(PG8_SB(1, 0), b3, voffB);
            PG8_BAR; PG8_WAIT_L(0); PG8_MMA(0, 1, At, B1); PG8_BAR;
            PG8_LDA(At, 1, 1); PG8_STAGE(PG8_SA(1, 0), a3, voffA);
            PG8_BAR; PG8_WAIT_L(0); PG8_MMA(1, 0, At, B0); PG8_BAR; PG8_SCHED;
            PG8_STAGE(PG8_SB(1, 1), b3 + hstep, voffB);
            PG8_WAIT_V(6); PG8_BAR; PG8_MMA(1, 1, At, B1); PG8_BAR;
            }
        }
        if constexpr (ALIGN_EPI) { if (wr == 0) PG8_BAR; }
        if constexpr (!Epi::AFTER_DRAIN) { E(acc, cur, wr, wc, fr, fq); S.done(cur); }
        if (!has_next) break;
#pragma unroll
        for (int a = 0; a < 2; ++a)
#pragma unroll
            for (int b = 0; b < 2; ++b)
#pragma unroll
                for (int m = 0; m < 4; ++m)
#pragma unroll
                    for (int n = 0; n < 2; ++n) acc[a][b][m][n] = (f32x4){0.f, 0.f, 0.f, 0.f};
        cur = nxt; cA = nA; cB = nB; ++ui;
        if constexpr (ALIGN_EPI) { if (wr == 1) PG8_BAR; }
    }
    PG8_WAIT_V(0);
    if constexpr (!ALIGN_EPI) { if (wr == 0) PG8_BAR; }
    PG8_BAR;
    if constexpr (Epi::AFTER_DRAIN) { E.fused(acc, cur, wr, wc, fr, fq, lds, wid, lane); S.done(cur); }
#undef PG8_SA
#undef PG8_SB
#undef PG8_STAGE
#undef PG8_LDA
#undef PG8_LDB
#undef PG8_MMA
#undef PG8_WAIT_V
#undef PG8_WAIT_L
#undef PG8_BAR
#undef PG8_SCHED
}
}

#define LAS __attribute__((address_space(3)))
typedef unsigned short bf16_t;
typedef short bf16x8 __attribute__((ext_vector_type(8)));
typedef float f32x4 __attribute__((ext_vector_type(4)));
typedef float f32x16 __attribute__((ext_vector_type(16)));
typedef unsigned u32x4 __attribute__((ext_vector_type(4)));
typedef unsigned u32x2 __attribute__((ext_vector_type(2)));
typedef float f32x2_t __attribute__((ext_vector_type(2)));
typedef __bf16 bf16x2_t __attribute__((ext_vector_type(2)));

constexpr int DM = 2048, NB = 4, SEQ = 2048, DEPTH = 4, NMETA = 16;
constexpr int LT = SEQ + NMETA;
constexpr int LP = 2112;
constexpr int MP = NB * LP;
constexpr int INC = 6160, INP = 6400;
constexpr int DFF = 5632, DFF2 = 11264;
constexpr float EPS = 1e-6f;
constexpr int NTHR = 512, NWAVE = 8;
constexpr int LDS_BYTES = 143360;
constexpr int HALO_OFF = 135168;

constexpr size_t al256(size_t x) { return (x + 255) & ~(size_t)255; }
constexpr size_t SZ_WIN = (size_t)INP * DM * 2, SZ_WOUT = (size_t)DM * DM * 2, SZ_WUP = (size_t)DFF2 * DM * 2, SZ_WDN = (size_t)DM * DFF * 2;
constexpr size_t WS_WIN = 0;
constexpr size_t WS_WOUT = WS_WIN + DEPTH * SZ_WIN;
constexpr size_t WS_WUP = WS_WOUT + DEPTH * SZ_WOUT;
constexpr size_t WS_WDN = WS_WUP + DEPTH * SZ_WUP;
constexpr size_t WS_X = WS_WDN + DEPTH * SZ_WDN;
constexpr size_t WS_H = WS_X + (size_t)MP * DM * 4;
constexpr size_t WS_P = WS_H + (size_t)MP * DM * 2;
constexpr size_t WS_VTA = WS_P + (size_t)MP * INP * 2;
constexpr size_t WS_VTB = WS_VTA + al256((size_t)NB * 1024 * LP * 2 + 4096);
constexpr size_t WS_OC = WS_VTB + al256((size_t)NB * 1024 * LP * 2 + 4096);
constexpr size_t WS_Y = WS_OC + (size_t)MP * DM * 2;
constexpr size_t WS_U = WS_Y + (size_t)MP * DM * 4;
constexpr size_t WS_G = WS_U + (size_t)MP * DFF2 * 2;
constexpr size_t WS_KV = WS_G + (size_t)MP * DFF * 2;
constexpr size_t WS_SP = WS_KV + (size_t)528 * 32768 * 4;
constexpr size_t WS_DEC = WS_SP + (size_t)528 * 65536;
constexpr size_t WS_PART = WS_DEC + (size_t)528 * 128 * 4;
constexpr size_t WS_CTL = WS_PART + (size_t)22 * 256 * DM * 4;
constexpr size_t CTL_BYTES = 16384;
constexpr size_t WS_END = WS_CTL + CTL_BYTES;

struct Params {
    const float *x, *meta, *pre_mix_g, *w_in, *da_lambda, *da_subln_g, *gate_w2, *gate_b, *gla_norm_g, *w_out, *post_mix_g, *pre_ffn_g, *w_up, *conv_w, *conv_b, *w_down, *post_ffn_g;
    float* out; unsigned char* ws; int ph_lo, ph_hi;
};

__device__ __forceinline__ unsigned pack2(float lo, float hi) { f32x2_t v = {lo, hi}; bf16x2_t b = __builtin_convertvector(v, bf16x2_t); return __builtin_bit_cast(unsigned, b); }
__device__ __forceinline__ float bf2f(unsigned short u) { return __uint_as_float(((unsigned)u) << 16); }
__device__ __forceinline__ float bflo(unsigned u) { return __uint_as_float(u << 16); }
__device__ __forceinline__ float bfhi(unsigned u) { return __uint_as_float(u & 0xffff0000u); }
__device__ __forceinline__ float wave_sum(float v) {
#pragma unroll
    for (int o = 1; o < 64; o <<= 1) v += __shfl_xor(v, o);
    return v;
}
#define MFMA32(a, b, c) __builtin_amdgcn_mfma_f32_32x32x16_bf16((a), (b), (c), 0, 0, 0)
__device__ __forceinline__ bf16x8 pack8(const f32x16& x, int s) {
    u32x4 p; p.x = pack2(x[8 * s + 0], x[8 * s + 1]); p.y = pack2(x[8 * s + 2], x[8 * s + 3]); p.z = pack2(x[8 * s + 4], x[8 * s + 5]); p.w = pack2(x[8 * s + 6], x[8 * s + 7]);
    return __builtin_bit_cast(bf16x8, p);
}
__device__ __forceinline__ int swap23(int i) { return (i & ~12) | ((i & 4) << 1) | ((i & 8) >> 1); }
__device__ __forceinline__ int crow(int r, int hi) { return (r & 3) + 8 * (r >> 2) + 4 * hi; }

struct TItem { const float* W; bf16_t* WT; int K, Nsrc, k0, n0, dn0; };
__device__ __forceinline__ void titem_load(const TItem& ti, float (&r)[64], int lane) {
    const int n = ti.n0 + lane; const bool ok = n < ti.Nsrc;
    const float* src = ti.W + (size_t)ti.k0 * ti.Nsrc + n;
#pragma unroll
    for (int i = 0; i < 64; ++i) r[i] = ok ? src[(size_t)i * ti.Nsrc] : 0.f;
}
__device__ __forceinline__ void titem_store(const TItem& ti, const float (&r)[64], LAS float* scr, int lane) {
#pragma unroll
    for (int i = 0; i < 64; ++i) scr[i * 65 + lane] = r[i];
    asm volatile("s_waitcnt lgkmcnt(0)" ::: "memory");
    const int c = lane & 7;
#pragma unroll
    for (int j = 0; j < 8; ++j) { const int nn = (lane >> 3) + 8 * j; const LAS float* s = scr + (8 * c) * 65 + nn;
        u32x4 o; o.x = pack2(s[0 * 65], s[1 * 65]); o.y = pack2(s[2 * 65], s[3 * 65]); o.z = pack2(s[4 * 65], s[5 * 65]); o.w = pack2(s[6 * 65], s[7 * 65]);
        *(u32x4*)(ti.WT + (size_t)(ti.dn0 + nn) * ti.K + ti.k0 + 8 * c) = o; }
    asm volatile("s_waitcnt lgkmcnt(0)" ::: "memory");
}

template <int MODE>
__device__ __forceinline__ void row_phase(const float* xin, const float* meta, float* outp, float* X, float* Xw, const float* Y, const float* PART, int nsplit, bf16_t* H, const float* g1, const float* g2, int gw, int ngw, int lane) {
    for (int row = gw; row < MP; row += ngw) {
        const int b = row / LP, t = row - b * LP;
        f32x4 xv[8];
        float* xr = X + (size_t)row * DM;
        if (MODE == 0) {
            const float* src = (t < NMETA) ? meta + (size_t)t * DM : xin + ((size_t)b * SEQ + (t - NMETA)) * DM;
#pragma unroll
            for (int j = 0; j < 8; ++j) xv[j] = (t < LT) ? *(const f32x4*)(src + 4 * (lane + 64 * j)) : (f32x4){0.f, 0.f, 0.f, 0.f};
        } else {
            const float* yr = Y + (size_t)row * DM;
            f32x4 yv[8]; float ss = 0.f;
            if (row >= 8192) {
#pragma unroll
                for (int j = 0; j < 8; ++j) yv[j] = (f32x4){0.f, 0.f, 0.f, 0.f};
                for (int kp = 0; kp < nsplit; ++kp) { const float* pr = PART + ((size_t)kp * 256 + (row - 8192)) * DM;
#pragma unroll
                    for (int j = 0; j < 8; ++j) yv[j] += *(const f32x4*)(pr + 4 * (lane + 64 * j)); }
            } else {
#pragma unroll
                for (int j = 0; j < 8; ++j) yv[j] = *(const f32x4*)(yr + 4 * (lane + 64 * j));
            }
#pragma unroll
            for (int j = 0; j < 8; ++j) { ss += (yv[j].x * yv[j].x + yv[j].y * yv[j].y) + (yv[j].z * yv[j].z + yv[j].w * yv[j].w); }
            const float r1 = rsqrtf(wave_sum(ss) * (1.f / DM) + EPS);
#pragma unroll
            for (int j = 0; j < 8; ++j) { const f32x4 g = *(const f32x4*)(g1 + 4 * (lane + 64 * j)); const f32x4 xo = *(const f32x4*)(xr + 4 * (lane + 64 * j)); xv[j] = xo + yv[j] * r1 * g; }
        }
        if (MODE == 2) {
            if (t >= NMETA && t < LT) { float* orow = outp + ((size_t)b * SEQ + (t - NMETA)) * DM;
#pragma unroll
                for (int j = 0; j < 8; ++j) *(f32x4*)(orow + 4 * (lane + 64 * j)) = xv[j]; }
        } else {
            float ss = 0.f;
            float* xw = Xw + (size_t)row * DM;
#pragma unroll
            for (int j = 0; j < 8; ++j) { *(f32x4*)(xw + 4 * (lane + 64 * j)) = xv[j]; ss += (xv[j].x * xv[j].x + xv[j].y * xv[j].y) + (xv[j].z * xv[j].z + xv[j].w * xv[j].w); }
            const float r2 = rsqrtf(wave_sum(ss) * (1.f / DM) + EPS);
            bf16_t* hr = H + (size_t)row * DM;
#pragma unroll
            for (int j = 0; j < 8; ++j) { const f32x4 g = *(const f32x4*)(g2 + 4 * (lane + 64 * j)); const f32x4 v = xv[j] * r2 * g;
                u32x2 w; w.x = pack2(v.x, v.y); w.y = pack2(v.z, v.w); *(u32x2*)(hr + 4 * (lane + 64 * j)) = w; }
        }
    }
}

__device__ __forceinline__ void conv_phase(const bf16_t* U, bf16_t* G, const float* cw, const float* cb, int gtid, int ngt) {
    constexpr int NCG = DFF / 8, NSTRIP = MP / 16;
    for (int it = gtid; it < NCG * NSTRIP; it += ngt) {
        const int s = it / NCG, cgp = it - s * NCG, j0 = 8 * cgp, row0 = 16 * s; const int t0 = row0 % LP;
        float wa[3][8], wv[3][8], ba[8], bv[8];
#pragma unroll
        for (int i = 0; i < 3; ++i)
#pragma unroll
            for (int e = 0; e < 8; e += 4) { const f32x4 a = *(const f32x4*)(cw + (size_t)i * DFF2 + j0 + e), v = *(const f32x4*)(cw + (size_t)i * DFF2 + DFF + j0 + e);
                wa[i][e] = a.x; wa[i][e + 1] = a.y; wa[i][e + 2] = a.z; wa[i][e + 3] = a.w; wv[i][e] = v.x; wv[i][e + 1] = v.y; wv[i][e + 2] = v.z; wv[i][e + 3] = v.w; }
#pragma unroll
        for (int e = 0; e < 8; e += 4) { const f32x4 a = *(const f32x4*)(cb + j0 + e), v = *(const f32x4*)(cb + DFF + j0 + e);
            ba[e] = a.x; ba[e + 1] = a.y; ba[e + 2] = a.z; ba[e + 3] = a.w; bv[e] = v.x; bv[e + 1] = v.y; bv[e + 2] = v.z; bv[e + 3] = v.w; }
        u32x4 a2 = {0, 0, 0, 0}, a1 = {0, 0, 0, 0}, v2 = {0, 0, 0, 0}, v1 = {0, 0, 0, 0};
        if (t0 > 0) { const bf16_t* u = U + (size_t)(row0 - 2) * DFF2 + j0; a2 = *(const u32x4*)u; v2 = *(const u32x4*)(u + DFF); a1 = *(const u32x4*)(u + DFF2); v1 = *(const u32x4*)(u + DFF2 + DFF); }
#pragma unroll 4
        for (int r = 0; r < 16; ++r) {
            const bf16_t* u = U + (size_t)(row0 + r) * DFF2 + j0;
            const u32x4 a0 = *(const u32x4*)u, v0 = *(const u32x4*)(u + DFF);
            unsigned ow[4];
#pragma unroll
            for (int q = 0; q < 4; ++q) {
                const float al = ba[2 * q] + wa[0][2 * q] * bflo(a2[q]) + wa[1][2 * q] * bflo(a1[q]) + wa[2][2 * q] * bflo(a0[q]);
                const float ah = ba[2 * q + 1] + wa[0][2 * q + 1] * bfhi(a2[q]) + wa[1][2 * q + 1] * bfhi(a1[q]) + wa[2][2 * q + 1] * bfhi(a0[q]);
                const float vl = bv[2 * q] + wv[0][2 * q] * bflo(v2[q]) + wv[1][2 * q] * bflo(v1[q]) + wv[2][2 * q] * bflo(v0[q]);
                const float vh = bv[2 * q + 1] + wv[0][2 * q + 1] * bfhi(v2[q]) + wv[1][2 * q + 1] * bfhi(v1[q]) + wv[2][2 * q + 1] * bfhi(v0[q]);
                const float gl = al / (1.f + __expf(-al)) * vl, gh = ah / (1.f + __expf(-ah)) * vh;
                ow[q] = pack2(gl, gh);
            }
            *(u32x4*)(G + (size_t)(row0 + r) * DFF + j0) = (u32x4){ow[0], ow[1], ow[2], ow[3]};
            a2 = a1; a1 = a0; v2 = v1; v1 = v0;
        }
    }
}
#define XB_TMO      128
#define XB_XCNT(j)  (256  + 64 * (j))
#define XB_XSUB(j)  (1280 + 64 * (j))
#define XB_XGEN(j)  (2304 + 64 * (j))
#define XB_TOP      3328
#define XB_TOPGEN   3392
#define XCD_BAR_WORDS 3456
#define XB_SPIN_CAP (1u << 18)

__device__ __forceinline__ unsigned xb_ld(unsigned* p)              { return __hip_atomic_load(p, __ATOMIC_RELAXED, __HIP_MEMORY_SCOPE_AGENT); }
__device__ __forceinline__ unsigned xb_add(unsigned* p, unsigned v) { return __hip_atomic_fetch_add(p, v, __ATOMIC_RELAXED, __HIP_MEMORY_SCOPE_AGENT); }
__device__ __forceinline__ unsigned xb_xcc_id() { return (unsigned)__builtin_amdgcn_s_getreg((3 << 11) | 20) & 0xFu; }
#define XB_SPIN(cond, bar) do { unsigned _sp = 0; while (cond) { __builtin_amdgcn_s_sleep(1); \
    if ((++_sp & 255u) == 0u) { if (xb_ld(&(bar)[XB_TMO])) break; if (_sp > XB_SPIN_CAP) { atomicAdd(&(bar)[XB_TMO], 1u); break; } } } } while (0)

struct XcdBarrier {
    unsigned* bar; unsigned x;
    volatile LAS unsigned* st;
};

__device__ __forceinline__ XcdBarrier xcd_barrier_post(unsigned* bar, volatile LAS unsigned* st) {
    XcdBarrier b; b.bar = bar; b.x = xb_xcc_id(); b.st = st;
    if (threadIdx.x == 0) (void)xb_add(&bar[XB_XCNT(b.x)], 1u);
    return b;
}
__device__ __forceinline__ void xcd_barrier_complete(unsigned* bar, unsigned x, unsigned& nloc, unsigned& nx) {
    const unsigned G = gridDim.x * gridDim.y * gridDim.z;
    unsigned sum, cnt, mine, sp = 0u;
    for (;;) {
        sum = 0u; cnt = 0u; mine = 0u;
#pragma unroll
        for (unsigned j = 0; j < 16; ++j) { const unsigned c = xb_ld(&bar[XB_XCNT(j)]); sum += c; cnt += (c > 0u) ? 1u : 0u; mine = (j == x) ? c : mine; }
        if (sum == G) break;
        __builtin_amdgcn_s_sleep(1);
        if ((++sp & 255u) == 0u) { if (xb_ld(&bar[XB_TMO])) break; if (sp > XB_SPIN_CAP) { atomicAdd(&bar[XB_TMO], 1u); break; } }
    }
    nloc = mine > 0u ? mine : 1u; nx = cnt > 0u ? cnt : 1u;
}

__device__ __forceinline__ void xcd_barrier(const XcdBarrier& b) {
    asm volatile("s_waitcnt vmcnt(0)" ::: "memory");
    __syncthreads();
    if (threadIdx.x == 0) {
        unsigned* bar = b.bar;
        __builtin_amdgcn_s_waitcnt(0);
        unsigned nloc = b.st[0], nx = b.st[1];
        if (nloc == 0u) { xcd_barrier_complete(bar, b.x, nloc, nx); b.st[0] = nloc; b.st[1] = nx; }
        const unsigned old = xb_add(&bar[XB_XSUB(b.x)], 1u);
        const unsigned gen = old / nloc;
        if (old + 1u == (gen + 1u) * nloc) {
            __builtin_amdgcn_fence(__ATOMIC_RELEASE, "agent");
            asm volatile("s_waitcnt vmcnt(0)" ::: "memory");
            const unsigned og = xb_add(&bar[XB_TOP], 1u);
            const unsigned tg = og / nx;
            if (og + 1u == (tg + 1u) * nx) xb_add(&bar[XB_TOPGEN], 1u);
            else XB_SPIN(xb_ld(&bar[XB_TOPGEN]) == tg, bar);
            __builtin_amdgcn_fence(__ATOMIC_ACQUIRE, "agent");
            xb_add(&bar[XB_XGEN(b.x)], 1u);
            asm volatile("s_waitcnt vmcnt(0)" ::: "memory");
        } else {
            XB_SPIN(xb_ld(&bar[XB_XGEN(b.x)]) == gen, bar);
            __builtin_amdgcn_fence(__ATOMIC_ACQUIRE, "agent");
            asm volatile("s_waitcnt vmcnt(0)" ::: "memory");
        }
    }
    __syncthreads();
}

constexpr int AT_KSTR = 144, AT_K1 = 64 * AT_KSTR  , AT_VOFF = 2 * AT_K1  , AT_BUF = AT_VOFF + 128 * AT_KSTR  ;
__device__ __forceinline__ void attn_unit(unsigned char* lds, const bf16_t* __restrict__ P, const bf16_t* __restrict__ Vt, bf16_t* __restrict__ OC, const float* subg_lds,
                                          int b, int h, int qt, float lam, float omli) {
    int tid_ = threadIdx.x; asm volatile("" : "+v"(tid_));
    const int tid = tid_, lane = tid & 63, w = __builtin_amdgcn_readfirstlane(tid >> 6), l31 = lane & 31, hi = lane >> 5;
    const int c = w >> 2, qb = w & 3;
    const int nkt = (2 * qt + 2 < 33) ? 2 * qt + 2 : 33;
    const int qrow0 = 128 * qt + 32 * qb;
    const bool active = qrow0 < LP;
    bf16x8 qf[4];
    {
        const bf16_t* qp = P + (size_t)(b * LP + (active ? qrow0 : 0) + l31) * INP + h * 128 + c * 64 + hi * 8;
#pragma unroll
        for (int ks = 0; ks < 4; ++ks) qf[ks] = *(const bf16x8*)(qp + 16 * ks);
    }
    f32x16 O[4];
#pragma unroll
    for (int v = 0; v < 4; ++v)
#pragma unroll
        for (int r = 0; r < 16; ++r) O[v][r] = 0.f;
    float m = -INFINITY, l = 0.f;
    const bf16_t* kbase = P + (size_t)(b * LP) * INP + 1024 + h * 128;
    const bf16_t* vbase = Vt + (size_t)(b * 1024 + h * 128) * LP;
    const int kkey0 = tid >> 4, kch = tid & 15;
    const int vdv0 = tid >> 3, vch = tid & 7;
    const bf16_t* ksrc = kbase + (size_t)kkey0 * INP + kch * 8;
    const bf16_t* vsrc = vbase + (size_t)vdv0 * LP + vch * 8;
    const int kdst = (kch >> 3) * AT_K1 + kkey0 * AT_KSTR + (kch & 7) * 16;
    const int vdst = AT_VOFF + vdv0 * AT_KSTR + vch * 16;
    u32x4 tk0, tk1, tv0, tv1;
#define AT_LOAD(kt) do { const bf16_t* ks_ = ksrc + (size_t)(64 * (kt)) * INP; tk0 = *(const u32x4*)ks_; tk1 = *(const u32x4*)(ks_ + (size_t)32 * INP); \
        const bf16_t* vs_ = vsrc + 64 * (kt); tv0 = *(const u32x4*)vs_; tv1 = *(const u32x4*)(vs_ + (size_t)64 * LP); } while (0)
#define AT_STORE(buf) do { unsigned char* d_ = lds + (buf) * AT_BUF; *(u32x4*)(d_ + kdst) = tk0; *(u32x4*)(d_ + kdst + 32 * AT_KSTR) = tk1; \
        *(u32x4*)(d_ + vdst) = tv0; *(u32x4*)(d_ + vdst + 64 * AT_KSTR) = tv1; } while (0)
    AT_LOAD(0); AT_STORE(0);
    __syncthreads();
    const int krow_off = c * AT_K1 + swap23(l31) * AT_KSTR + hi * 16;
    const int vrow_off = AT_VOFF + l31 * AT_KSTR + hi * 16;
    for (int kt = 0; kt < nkt; ++kt) {
        const bool more = kt + 1 < nkt;
        if (more) AT_LOAD(kt + 1);
        const unsigned char* buf = lds + (kt & 1) * AT_BUF;
        if (active && 64 * kt <= qrow0 + 31) {
            f32x16 s0, s1;
#pragma unroll
            for (int r = 0; r < 16; ++r) { s0[r] = 0.f; s1[r] = 0.f; }
#pragma unroll
            for (int ks = 0; ks < 4; ++ks) {
                const bf16x8 k0 = *(const bf16x8*)(buf + krow_off + ks * 32), k1 = *(const bf16x8*)(buf + krow_off + 32 * AT_KSTR + ks * 32);
                s0 = MFMA32(k0, qf[ks], s0); s1 = MFMA32(k1, qf[ks], s1);
            }
            if (64 * kt + 63 > qrow0) {
                const int q = qrow0 + l31, kb0 = 64 * kt + 8 * hi;
#pragma unroll
                for (int r = 0; r < 16; ++r) { const int key = kb0 + 16 * (r >> 3) + (r & 7); if (key > q) s0[r] = -INFINITY; if (key + 32 > q) s1[r] = -INFINITY; }
            }
            float mx = fmaxf(s0[0], s1[0]);
#pragma unroll
            for (int r = 1; r < 16; ++r) mx = fmaxf(mx, fmaxf(s0[r], s1[r]));
            mx = fmaxf(mx, __shfl_xor(mx, 32));
            const float mn = fmaxf(m, mx), alpha = __builtin_amdgcn_exp2f(m - mn);
            m = mn;
            float sum = 0.f;
#pragma unroll
            for (int r = 0; r < 16; ++r) { s0[r] = __builtin_amdgcn_exp2f(s0[r] - mn); s1[r] = __builtin_amdgcn_exp2f(s1[r] - mn); sum += s0[r] + s1[r]; }
            l = l * alpha + sum;
#pragma unroll
            for (int v = 0; v < 4; ++v)
#pragma unroll
                for (int r = 0; r < 16; ++r) O[v][r] *= alpha;
            const bf16x8 p00 = pack8(s0, 0), p01 = pack8(s0, 1), p10 = pack8(s1, 0), p11 = pack8(s1, 1);
#pragma unroll
            for (int v = 0; v < 4; ++v) {
                const unsigned char* vp = buf + vrow_off + v * 32 * AT_KSTR;
                const bf16x8 a0 = *(const bf16x8*)(vp), a1 = *(const bf16x8*)(vp + 32), a2 = *(const bf16x8*)(vp + 64), a3 = *(const bf16x8*)(vp + 96);
                O[v] = MFMA32(a0, p00, O[v]); O[v] = MFMA32(a1, p01, O[v]); O[v] = MFMA32(a2, p10, O[v]); O[v] = MFMA32(a3, p11, O[v]);
            }
        }
        if (more) AT_STORE((kt + 1) & 1);
        __syncthreads();
    }
#undef AT_LOAD
#undef AT_STORE
    l += __shfl_xor(l, 32);
    const float inv = 1.f / l;
    float* ex = (float*)lds + (size_t)qb * 4096;
    if (c == 1 && active) {
#pragma unroll
        for (int v = 0; v < 4; ++v)
#pragma unroll
            for (int r = 0; r < 16; ++r) ex[(v * 16 + r) * 64 + lane] = O[v][r] * inv;
    }
    __syncthreads();
    if (c == 0 && active) {
        float ss = 0.f;
#pragma unroll
        for (int v = 0; v < 4; ++v)
#pragma unroll
            for (int r = 0; r < 16; ++r) { const float o = O[v][r] * inv - lam * ex[(v * 16 + r) * 64 + lane]; O[v][r] = o; ss += o * o; }
        ss += __shfl_xor(ss, 32);
        const float rs = rsqrtf(ss * (1.f / 128.f) + EPS) * omli;
        bf16_t* orow = OC + (size_t)(b * LP + qrow0 + l31) * DM + h * 128;
#pragma unroll
        for (int v = 0; v < 4; ++v)
#pragma unroll
            for (int r4 = 0; r4 < 4; ++r4) { const int dv = 32 * v + 8 * r4 + 4 * hi; const f32x4 g = *(const f32x4*)(subg_lds + dv);
                u32x2 wv; wv.x = pack2(O[v][4 * r4] * rs * g.x, O[v][4 * r4 + 1] * rs * g.y); wv.y = pack2(O[v][4 * r4 + 2] * rs * g.z, O[v][4 * r4 + 3] * rs * g.w);
                *(u32x2*)(orow + dv) = wv; }
    }
    __syncthreads();
}

constexpr int GL_QSTR = 272, GL_TSTR = 144;
constexpr int GL_QIN = 0, GL_KIN = 64 * GL_QSTR  , GL_KOUT = 2 * 64 * GL_QSTR  , GL_VT = GL_KOUT + 128 * GL_TSTR  , GL_LR = GL_VT + 256 * GL_TSTR  ,
              GL_SEG = GL_LR + 4096, GL_DEC = GL_SEG + 2048, GL_NG = GL_DEC + 512, GL_RAWQ = GL_NG + 1024  , GL_RAWK = GL_RAWQ + 16384, GL_END = GL_RAWK + 16384  ;
constexpr int GL_OSTR = 260;
constexpr int NCHUNK = LP / 64, NGU = 16 * NCHUNK;

#define GL_GATE() \
        float bc[16]; float run = 0.f; \
        _Pragma("unroll") for (int i = 0; i < 16; ++i) { \
            const float* lr = LR + (16 * seg + i) * 16; float z = b2r; \
            _Pragma("unroll") for (int j = 0; j < 16; j += 4) { const f32x4 v = *(const f32x4*)(lr + j); z += v.x * w2r[j] + v.y * w2r[j + 1] + v.z * w2r[j + 2] + v.w * w2r[j + 3]; } \
            const float ls = fminf(z, 0.f) - __logf(1.f + __expf(-fabsf(z))); \
            run += ls * (1.f / 16.f); bc[i] = run; } \
        SEG[seg * 128 + d] = run; \
        __syncthreads(); \
        float off = 0.f, tot = 0.f; \
        _Pragma("unroll") for (int s = 0; s < 4; ++s) { const float v = SEG[s * 128 + d]; tot += v; if (s < seg) off += v; }

__device__ __forceinline__ void gla_m1(unsigned char* lds, const bf16_t* __restrict__ P, const bf16_t* __restrict__ Vt, float* __restrict__ KV, float* __restrict__ DECb,
                                       const float* __restrict__ w2, const float* __restrict__ b2, int u) {
    int tid_ = threadIdx.x; asm volatile("" : "+v"(tid_));
    const int tid = tid_, lane = tid & 63, w = __builtin_amdgcn_readfirstlane(tid >> 6), l31 = lane & 31, hi = lane >> 5;
    const int bh = u / NCHUNK, n = u - bh * NCHUNK, b = bh >> 2, h = bh & 3;
    const int d = tid & 127, seg = tid >> 7;
    float w2r[16];
#pragma unroll
    for (int j = 0; j < 16; ++j) w2r[j] = w2[(size_t)j * 512 + h * 128 + d];
    const float b2r = b2[h * 128 + d];
    float* LR = (float*)(lds + GL_LR); float* SEG = (float*)(lds + GL_SEG);
    const int tok8 = tid >> 3, part = tid & 7;
    const size_t R0 = (size_t)b * LP + 64 * n;
    const unsigned lrw = *(const unsigned*)(P + (R0 + tok8) * INP + 6144 + 2 * part);
    { const bf16_t* kp = P + (R0 + (tid >> 4)) * INP + 3584 + h * 128 + (tid & 15) * 8;
      const u32x4 k0 = *(const u32x4*)kp, k1 = *(const u32x4*)(kp + (size_t)32 * INP);
      unsigned char* rk = lds + GL_RAWK + (tid >> 4) * 256 + (tid & 15) * 16;
      *(u32x4*)rk = k0; *(u32x4*)(rk + 32 * 256) = k1; }
    u32x4 vt[4];
    { const bf16_t* vp = Vt + ((size_t)b * 1024 + h * 256 + (tid >> 3)) * LP + 64 * n + (tid & 7) * 8;
#pragma unroll
      for (int i = 0; i < 4; ++i) vt[i] = *(const u32x4*)(vp + (size_t)(64 * i) * LP); }
    LR[tok8 * 16 + 2 * part] = bflo(lrw); LR[tok8 * 16 + 2 * part + 1] = bfhi(lrw);
    __syncthreads();
    GL_GATE()
    if (seg == 0) DECb[(size_t)u * 128 + d] = __expf(tot);
    {
        unsigned ko[8];
#pragma unroll
        for (int i = 0; i < 16; i += 2) {
            const float b0 = bc[i] + off, b1 = bc[i + 1] + off;
            const bf16_t* rk = (const bf16_t*)(lds + GL_RAWK + (16 * seg + i) * 256) + d;
            ko[i >> 1] = pack2(bf2f(rk[0]) * __expf(tot - b0), bf2f(rk[128]) * __expf(tot - b1));
        }
        unsigned char* kod = lds + GL_KOUT + d * GL_TSTR + seg * 32;
        *(u32x4*)kod = (u32x4){ko[0], ko[1], ko[2], ko[3]}; *(u32x4*)(kod + 16) = (u32x4){ko[4], ko[5], ko[6], ko[7]};
#pragma unroll
        for (int i = 0; i < 4; ++i) *(u32x4*)(lds + GL_VT + ((tid >> 3) + 64 * i) * GL_TSTR + (tid & 7) * 16) = vt[i];
    }
    __syncthreads();
    const unsigned char* va = lds + GL_VT + (32 * w + l31) * GL_TSTR + hi * 16;
    const bf16x8 v0 = *(const bf16x8*)(va), v1 = *(const bf16x8*)(va + 32), v2 = *(const bf16x8*)(va + 64), v3 = *(const bf16x8*)(va + 96);
    float* kvo = KV + (size_t)u * 32768 + (size_t)(w * 4) * 1024 + lane;
#pragma unroll
    for (int kb = 0; kb < 4; ++kb) {
        f32x16 S;
#pragma unroll
        for (int r = 0; r < 16; ++r) S[r] = 0.f;
        const unsigned char* ko = lds + GL_KOUT + (32 * kb + l31) * GL_TSTR + hi * 16;
        S = MFMA32(*(const bf16x8*)(ko), v0, S); S = MFMA32(*(const bf16x8*)(ko + 32), v1, S);
        S = MFMA32(*(const bf16x8*)(ko + 64), v2, S); S = MFMA32(*(const bf16x8*)(ko + 96), v3, S);
#pragma unroll
        for (int r = 0; r < 16; ++r) kvo[(kb * 16 + r) * 64] = S[r];
    }
}

__device__ __forceinline__ void gla_scan(const float* __restrict__ KV, const float* __restrict__ DECb, u32x4* __restrict__ SP, int g) {
    const int lane = g & 63, s = (g >> 6) & 1, kb = (g >> 7) & 3, w = (g >> 9) & 7, bh = g >> 12, hi = lane >> 5;
    const float* kv = KV + (size_t)(bh * NCHUNK) * 32768 + (size_t)((w * 4 + kb) * 16 + 8 * s) * 64 + lane;
    const float* dc = DECb + (size_t)(bh * NCHUNK) * 128 + 32 * kb + 16 * s + 4 * hi;
    u32x4* sp = SP + (size_t)(bh * NCHUNK) * 4096 + ((w * 4 + kb) * 2 + s) * 64 + lane;
    float S[8];
#pragma unroll
    for (int j = 0; j < 8; ++j) S[j] = 0.f;
#pragma unroll 3
    for (int n = 0; n < NCHUNK; ++n) {
        float t[8];
#pragma unroll
        for (int j = 0; j < 8; ++j) t[j] = kv[(size_t)n * 32768 + j * 64];
        const f32x4 d0 = *(const f32x4*)(dc + (size_t)n * 128), d1 = *(const f32x4*)(dc + (size_t)n * 128 + 8);
        sp[(size_t)n * 4096] = (u32x4){pack2(S[0], S[1]), pack2(S[2], S[3]), pack2(S[4], S[5]), pack2(S[6], S[7])};
        S[0] = S[0] * d0.x + t[0]; S[1] = S[1] * d0.y + t[1]; S[2] = S[2] * d0.z + t[2]; S[3] = S[3] * d0.w + t[3];
        S[4] = S[4] * d1.x + t[4]; S[5] = S[5] * d1.y + t[5]; S[6] = S[6] * d1.z + t[6]; S[7] = S[7] * d1.w + t[7];
    }
}

__device__ __forceinline__ void gla_m3(unsigned char* lds, const bf16_t* __restrict__ P, const bf16_t* __restrict__ Vt, const u32x4* __restrict__ SP, bf16_t* __restrict__ OC,
                                       const float* __restrict__ w2, const float* __restrict__ b2, const float* __restrict__ ng, int u) {
    int tid_ = threadIdx.x; asm volatile("" : "+v"(tid_));
    const int tid = tid_, lane = tid & 63, w = __builtin_amdgcn_readfirstlane(tid >> 6), l31 = lane & 31, hi = lane >> 5;
    const int bh = u / NCHUNK, n = u - bh * NCHUNK, b = bh >> 2, h = bh & 3;
    const int d = tid & 127, seg = tid >> 7;
    float w2r[16];
#pragma unroll
    for (int j = 0; j < 16; ++j) w2r[j] = w2[(size_t)j * 512 + h * 128 + d];
    const float b2r = b2[h * 128 + d];
    float* LR = (float*)(lds + GL_LR); float* SEG = (float*)(lds + GL_SEG); float* NG = (float*)(lds + GL_NG);
    if (tid < 256) NG[tid] = ng[tid];
    const int dpos = swap23(d);
    const int tok8 = tid >> 3, part = tid & 7;
    const size_t R0 = (size_t)b * LP + 64 * n;
    const unsigned lrw = *(const unsigned*)(P + (R0 + tok8) * INP + 6144 + 2 * part);
    { const bf16_t* qp = P + (R0 + (tid >> 4)) * INP + 3072 + h * 128 + (tid & 15) * 8;
      const u32x4 q0 = *(const u32x4*)qp, q1 = *(const u32x4*)(qp + (size_t)32 * INP), k0 = *(const u32x4*)(qp + 512), k1 = *(const u32x4*)(qp + (size_t)32 * INP + 512);
      unsigned char* rq = lds + GL_RAWQ + (tid >> 4) * 256 + (tid & 15) * 16;
      *(u32x4*)rq = q0; *(u32x4*)(rq + 32 * 256) = q1; *(u32x4*)(rq + 16384) = k0; *(u32x4*)(rq + 16384 + 32 * 256) = k1; }
    u32x4 vt[4];
    { const bf16_t* vp = Vt + ((size_t)b * 1024 + h * 256 + (tid >> 3)) * LP + 64 * n + (tid & 7) * 8;
#pragma unroll
      for (int i = 0; i < 4; ++i) vt[i] = *(const u32x4*)(vp + (size_t)(64 * i) * LP); }
    LR[tok8 * 16 + 2 * part] = bflo(lrw); LR[tok8 * 16 + 2 * part + 1] = bfhi(lrw);
    __syncthreads();
    GL_GATE()
    {
#pragma unroll
        for (int i = 0; i < 16; i += 2) {
            const float b0 = bc[i] + off, b1 = bc[i + 1] + off;
            const bf16_t* rq = (const bf16_t*)(lds + GL_RAWQ + (16 * seg + i) * 256) + d;
            const float q0 = bf2f(rq[0]) * __expf(b0) * 0.08838834764831845f, q1 = bf2f(rq[128]) * __expf(b1) * 0.08838834764831845f;
            const float k0 = bf2f(rq[8192]), k1 = bf2f(rq[8192 + 128]);
            const unsigned qq = pack2(q0, q1), kk = pack2(k0 * __expf(-b0), k1 * __expf(-b1));
            bf16_t* qd = (bf16_t*)(lds + GL_QIN + (16 * seg + i) * GL_QSTR) + dpos; bf16_t* kd = (bf16_t*)(lds + GL_KIN + (16 * seg + i) * GL_QSTR) + dpos;
            qd[0] = (bf16_t)(qq & 0xffffu); qd[GL_QSTR / 2] = (bf16_t)(qq >> 16); kd[0] = (bf16_t)(kk & 0xffffu); kd[GL_QSTR / 2] = (bf16_t)(kk >> 16);
        }
#pragma unroll
        for (int i = 0; i < 4; ++i) *(u32x4*)(lds + GL_VT + ((tid >> 3) + 64 * i) * GL_TSTR + (tid & 7) * 16) = vt[i];
    }
    u32x4 sp[8];
    { const u32x4* spp = SP + (size_t)u * 4096 + (size_t)(w * 8) * 64 + lane;
#pragma unroll
      for (int i = 0; i < 8; ++i) sp[i] = spp[i * 64]; }
    __syncthreads();
    f32x16 X00, X01, X11;
#pragma unroll
    for (int r = 0; r < 16; ++r) { X00[r] = 0.f; X01[r] = 0.f; X11[r] = 0.f; }
    {
        const unsigned char* ka = lds + GL_KIN + swap23(l31) * GL_QSTR + hi * 16;
        const unsigned char* qa = lds + GL_QIN + l31 * GL_QSTR + hi * 16;
#pragma unroll 2
        for (int ks = 0; ks < 8; ++ks) {
            const bf16x8 k0 = *(const bf16x8*)(ka + ks * 32), k1 = *(const bf16x8*)(ka + 32 * GL_QSTR + ks * 32);
            const bf16x8 q0 = *(const bf16x8*)(qa + ks * 32), q1 = *(const bf16x8*)(qa + 32 * GL_QSTR + ks * 32);
            X00 = MFMA32(k0, q0, X00); X01 = MFMA32(k0, q1, X01); X11 = MFMA32(k1, q1, X11);
        }
#pragma unroll
        for (int r = 0; r < 16; ++r) { const int j = 16 * (r >> 3) + 8 * hi + (r & 7); if (j > l31) { X00[r] = 0.f; X11[r] = 0.f; } }
    }
    f32x16 Oa, Ob; u32x4 go[4];
#pragma unroll
    for (int r = 0; r < 16; ++r) { Oa[r] = 0.f; Ob[r] = 0.f; }
    {
        const unsigned char* va = lds + GL_VT + (32 * w + l31) * GL_TSTR + hi * 16;
        const bf16x8 v0 = *(const bf16x8*)(va), v1 = *(const bf16x8*)(va + 32), v2 = *(const bf16x8*)(va + 64), v3 = *(const bf16x8*)(va + 96);
        Oa = MFMA32(pack8(X00, 0), v0, Oa); Oa = MFMA32(pack8(X00, 1), v1, Oa);
        Ob = MFMA32(pack8(X01, 0), v0, Ob); Ob = MFMA32(pack8(X01, 1), v1, Ob);
        Ob = MFMA32(pack8(X11, 0), v2, Ob); Ob = MFMA32(pack8(X11, 1), v3, Ob);
        { const bf16_t* gp = P + (R0 + tok8) * INP + 5120 + h * 256 + 32 * part;
#pragma unroll
          for (int i = 0; i < 4; ++i) go[i] = *(const u32x4*)(gp + 8 * i); }
        const unsigned char* qa = lds + GL_QIN + l31 * GL_QSTR + hi * 16;
#pragma unroll
        for (int kb = 0; kb < 4; ++kb)
#pragma unroll
            for (int s = 0; s < 2; ++s) {
                const bf16x8 sb = __builtin_bit_cast(bf16x8, sp[kb * 2 + s]);
                const bf16x8 q0 = *(const bf16x8*)(qa + kb * 64 + s * 32), q1 = *(const bf16x8*)(qa + 32 * GL_QSTR + kb * 64 + s * 32);
                Oa = MFMA32(q0, sb, Oa); Ob = MFMA32(q1, sb, Ob);
            }
    }
    __syncthreads();
    {
        float* ost = (float*)lds;
#pragma unroll
        for (int r = 0; r < 16; ++r) { ost[crow(r, hi) * GL_OSTR + 32 * w + l31] = Oa[r]; ost[(32 + crow(r, hi)) * GL_OSTR + 32 * w + l31] = Ob[r]; }
    }
    __syncthreads();
    {
        const float* orow = (const float*)lds + tok8 * GL_OSTR + 32 * part;
        f32x4 ov[8]; float ss = 0.f;
#pragma unroll
        for (int i = 0; i < 8; ++i) { ov[i] = *(const f32x4*)(orow + 4 * i); ss += (ov[i].x * ov[i].x + ov[i].y * ov[i].y) + (ov[i].z * ov[i].z + ov[i].w * ov[i].w); }
        ss += __shfl_xor(ss, 1); ss += __shfl_xor(ss, 2); ss += __shfl_xor(ss, 4);
        const float rs = rsqrtf(ss * (1.f / 256.f) + EPS);
        bf16_t* od = OC + (R0 + tok8) * DM + 1024 + h * 256 + 32 * part;
#pragma unroll
        for (int i = 0; i < 4; ++i) {
            unsigned ow[4];
#pragma unroll
            for (int q = 0; q < 4; ++q) {
                const int e = 8 * i + 2 * q; const f32x4 o4 = ov[e >> 2]; const float o0 = (e & 2) ? o4.z : o4.x, o1 = (e & 2) ? o4.w : o4.y;
                const float g0 = bflo(go[i][q]), g1 = bfhi(go[i][q]);
                ow[q] = pack2(o0 * rs * NG[32 * part + e] * (g0 / (1.f + __expf(-g0))), o1 * rs * NG[32 * part + e + 1] * (g1 / (1.f + __expf(-g1))));
            }
            *(u32x4*)(od + 8 * i) = (u32x4){ow[0], ow[1], ow[2], ow[3]};
        }
    }
}

constexpr int PTAB = 134144;
#ifndef RP_PRO
#define RP_PRO 1
#endif
#ifndef RP_MIX
#define RP_MIX 1
#endif
#ifndef RP_G3
#define RP_G3 1
#endif
#ifndef RP_G4
#define RP_G4 1
#endif
#ifndef RP_GLA
#define RP_GLA 1
#endif
#ifndef RP_ATT
#define RP_ATT 1
#endif
#ifndef RP_M1
#define RP_M1 1
#endif
#ifndef RP_SCAN
#define RP_SCAN 1
#endif
#ifndef RP_M3
#define RP_M3 1
#endif
#ifndef RP_BAR
#define RP_BAR 1
#endif
#ifndef RP_G1
#define RP_G1 1
#endif
#ifndef RP_G2
#define RP_G2 1
#endif
#ifndef RP_CONV
#define RP_CONV 1
#endif
enum { T_X = 0, T_META, T_PRE_MIX_G, T_W_IN, T_DA_LAMBDA, T_DA_SUBLN_G, T_GATE_W2, T_GATE_B, T_GLA_NORM_G, T_W_OUT, T_POST_MIX_G, T_PRE_FFN_G, T_W_UP, T_CONV_W, T_CONV_B, T_W_DOWN, T_POST_FFN_G, T_OUT, T_WS, T_N };
__device__ __forceinline__ unsigned long long ldp_(const unsigned char* lds, int i) {
    const unsigned long long v = ((const volatile unsigned long long*)(lds + PTAB))[i];
    const unsigned lo = __builtin_amdgcn_readfirstlane((unsigned)v), hi = __builtin_amdgcn_readfirstlane((unsigned)(v >> 32));
    return ((unsigned long long)hi << 32) | lo;
}
#define LDF(i) ((const float*)ldp_(lds, (i)))
#define LDWS() ((unsigned char*)ldp_(lds, T_WS))
__global__ void __launch_bounds__(NTHR) hymba_fwd(Params p) {
    extern __shared__ __attribute__((aligned(16))) unsigned char lds[];
    cg::grid_group grid = cg::this_grid();
    if (threadIdx.x == 0) {
        unsigned long long* tab = (unsigned long long*)(lds + PTAB);
        tab[T_X] = (unsigned long long)p.x; tab[T_META] = (unsigned long long)p.meta; tab[T_PRE_MIX_G] = (unsigned long long)p.pre_mix_g; tab[T_W_IN] = (unsigned long long)p.w_in;
        tab[T_DA_LAMBDA] = (unsigned long long)p.da_lambda; tab[T_DA_SUBLN_G] = (unsigned long long)p.da_subln_g; tab[T_GATE_W2] = (unsigned long long)p.gate_w2; tab[T_GATE_B] = (unsigned long long)p.gate_b;
        tab[T_GLA_NORM_G] = (unsigned long long)p.gla_norm_g; tab[T_W_OUT] = (unsigned long long)p.w_out; tab[T_POST_MIX_G] = (unsigned long long)p.post_mix_g; tab[T_PRE_FFN_G] = (unsigned long long)p.pre_ffn_g;
        tab[T_W_UP] = (unsigned long long)p.w_up; tab[T_CONV_W] = (unsigned long long)p.conv_w; tab[T_CONV_B] = (unsigned long long)p.conv_b; tab[T_W_DOWN] = (unsigned long long)p.w_down;
        tab[T_POST_FFN_G] = (unsigned long long)p.post_ffn_g; tab[T_OUT] = (unsigned long long)p.out; tab[T_WS] = (unsigned long long)p.ws;
    }
    if (threadIdx.x == 0) { volatile LAS unsigned* st = (volatile LAS unsigned*)((LAS unsigned char*)lds + PTAB + 256); st[0] = 0u; st[1] = 0u; }
    __syncthreads();
    if ((p.ph_hi - p.ph_lo) > 1) (void)xcd_barrier_post((unsigned*)(p.ws + WS_CTL), (volatile LAS unsigned*)((LAS unsigned char*)lds + PTAB + 256));
    const int lo = p.ph_lo, hi_ = p.ph_hi; const bool multi = (hi_ - lo) > 1;
    int ph = 0;
#define IN_PH() (ph >= lo && ph < hi_)
#define SEAM() do { ++ph; if (multi) { if (ph == 1) grid.sync(); else { XcdBarrier xb_; xb_.bar = (unsigned*)(LDWS() + WS_CTL); xb_.x = xb_xcc_id(); xb_.st = (volatile LAS unsigned*)((LAS unsigned char*)lds + PTAB + 256); for (int r3 = 0; r3 < RP_BAR; ++r3) xcd_barrier(xb_); } } } while (0)
#define PH_VARS() int tid_ = threadIdx.x; asm volatile("" : "+v"(tid_)); int bx = blockIdx.x; asm volatile("" : "+s"(bx)); const int G = gridDim.x; \
    const int tid = tid_, lane = tid & 63, wave = __builtin_amdgcn_readfirstlane(tid >> 6); const int gw = bx * NWAVE + wave, ngw = G * NWAVE; \
    unsigned char* ws = LDWS(); LAS unsigned char* ldsa = (LAS unsigned char*)lds; (void)lane; (void)gw; (void)ngw; (void)ldsa; (void)ws

#ifndef NO_PRO
    for (int rp = 0; rp < RP_PRO; ++rp) if (IN_PH()) {
        PH_VARS();
        LAS float* scr = (LAS float*)(ldsa + wave * 16640);
        constexpr int NB_IN = INP / 64, NB_D = DM / 64, NB_UP = DFF2 / 64;
        constexpr int I_IN = (DM / 64) * NB_IN, I_OUT = (DM / 64) * NB_D, I_UP = (DM / 64) * NB_UP, I_DN = (DFF / 64) * NB_D, I_L = I_IN + I_OUT + I_UP + I_DN;
        const float* w_in = LDF(T_W_IN); const float* w_out = LDF(T_W_OUT); const float* w_up = LDF(T_W_UP); const float* w_dn = LDF(T_W_DOWN);
#define TDEC(ti, it_) do { const int l_ = (it_) / I_L; int r_ = (it_) - l_ * I_L; int nblk_; \
            if (r_ < I_IN) { ti.W = w_in + (size_t)l_ * DM * INC; ti.WT = (bf16_t*)(ws + WS_WIN) + (size_t)l_ * INP * DM; ti.K = DM; ti.Nsrc = INC; nblk_ = NB_IN; } \
            else if ((r_ -= I_IN) < I_OUT) { ti.W = w_out + (size_t)l_ * DM * DM; ti.WT = (bf16_t*)(ws + WS_WOUT) + (size_t)l_ * DM * DM; ti.K = DM; ti.Nsrc = DM; nblk_ = NB_D; } \
            else if ((r_ -= I_OUT) < I_UP) { ti.W = w_up + (size_t)l_ * DM * DFF2; ti.WT = (bf16_t*)(ws + WS_WUP) + (size_t)l_ * DFF2 * DM; ti.K = DM; ti.Nsrc = DFF2; nblk_ = NB_UP; } \
            else { r_ -= I_UP; ti.W = w_dn + (size_t)l_ * DFF * DM; ti.WT = (bf16_t*)(ws + WS_WDN) + (size_t)l_ * DM * DFF; ti.K = DFF; ti.Nsrc = DM; nblk_ = NB_D; } \
            const int kb_ = r_ / nblk_; ti.k0 = 64 * kb_; ti.n0 = 64 * (r_ - kb_ * nblk_); ti.dn0 = ti.n0; \
            if (ti.Nsrc == DFF2) { const int j_ = ti.n0 < DFF ? ti.n0 : ti.n0 - DFF; ti.dn0 = 256 * (j_ >> 7) + (j_ & 127) + (ti.n0 < DFF ? 0 : 128); } } while (0)
        {
            constexpr int NIT = DEPTH * I_L;
            float ra[64], rb[64]; TItem ta, tb;
            int it = gw;
            if (it < NIT) {
                TDEC(ta, it); titem_load(ta, ra, lane);
                for (;;) {
                    const int itb = it + ngw; const bool vb = itb < NIT;
                    if (vb) { TDEC(tb, itb); titem_load(tb, rb, lane); }
                    titem_store(ta, ra, scr, lane);
                    if (!vb) break;
                    it = itb + ngw; const bool va = it < NIT;
                    if (va) { TDEC(ta, it); titem_load(ta, ra, lane); }
                    titem_store(tb, rb, scr, lane);
                    if (!va) break;
                }
            }
        }
#undef TDEC
        row_phase<0>(LDF(T_X), LDF(T_META), nullptr, (float*)(ws + WS_X), (float*)(ws + WS_X), nullptr, nullptr, 0, (bf16_t*)(ws + WS_H), nullptr, LDF(T_PRE_MIX_G), gw, ngw, lane);
    }
#endif
    SEAM();

    for (int l = 0; l < DEPTH; ++l) {
        for (int rp = 0; rp < RP_G1; ++rp) if (IN_PH()) {
            PH_VARS();
            pg8::Gemm g{(bf16_t*)(ws + WS_H), (bf16_t*)(ws + WS_WIN) + (size_t)l * INP * DM, MP, INP, DM}; pg8::StaticOrder S; S.init(MP, INP, G, bx);
            pg8::EpiIn E{(bf16_t*)(ws + WS_P), INP, (bf16_t*)(ws + WS_VTA), (bf16_t*)(ws + WS_VTB), LP, 0.125f * 1.4426950408889634f};
#ifndef NO_G1
            pg8::gemm_phase<pg8::EpiIn, pg8::StaticOrder, true, true>(ldsa, g, S, E);
#endif
        }
        SEAM();
        for (int sub = 0; sub < 3; ++sub) {
            for (int rp = 0; rp < RP_MIX; ++rp) if (IN_PH()) {
                PH_VARS();
                const bf16_t* P = (const bf16_t*)(ws + WS_P); bf16_t* OC = (bf16_t*)(ws + WS_OC);
                if (sub == 1) {
                    for (int r2 = 0; r2 < RP_SCAN; ++r2) if (tid < 256 && bx * 256 + tid < 65536) gla_scan((const float*)(ws + WS_KV), (const float*)(ws + WS_DEC), (u32x4*)(ws + WS_SP), bx * 256 + tid);
                } else {
                    if (sub == 0) { for (int r2 = 0; r2 < RP_M1; ++r2) for (int u = G - 1 - bx; u < NGU; u += G) gla_m1(lds, P, (const bf16_t*)(ws + WS_VTB), (float*)(ws + WS_KV), (float*)(ws + WS_DEC), LDF(T_GATE_W2) + (size_t)l * 16 * 512, LDF(T_GATE_B) + (size_t)l * 512, u); }
                    else { for (int r2 = 0; r2 < RP_M3; ++r2) for (int u = bx; u < NGU; u += G) gla_m3(lds, P, (const bf16_t*)(ws + WS_VTB), (const u32x4*)(ws + WS_SP), OC, LDF(T_GATE_W2) + (size_t)l * 16 * 512, LDF(T_GATE_B) + (size_t)l * 512, LDF(T_GLA_NORM_G) + (size_t)l * 256, u); }
                    __syncthreads();
                    float* subg = (float*)(lds + 80000); float* lamw = subg + 128;
                    const float lam_init = 0.8f - 0.6f * __expf(-0.3f * (float)l);
                    if (tid < 128) subg[tid] = LDF(T_DA_SUBLN_G)[(size_t)l * 128 + tid];
                    if (wave == 0) { const float* lv = LDF(T_DA_LAMBDA) + (size_t)l * 256; const float a = wave_sum(lv[lane] * lv[64 + lane]), c2 = wave_sum(lv[128 + lane] * lv[192 + lane]);
                        if (lane == 0) lamw[0] = __expf(a) - __expf(c2) + lam_init; }
                    __syncthreads();
                    const float lam = lamw[0];
                    for (int ra = 0; ra < RP_ATT; ++ra) for (int k = (sub == 0 ? 0 : 2); k * G < 544 && (sub != 0 || k < 2); ++k) {
                        const int j = (k < 2) ? k * G + ((k & 1) ? (G - 1 - bx) : bx) : k * G + (bx - 16);
                        if (j < 544 && j >= k * G) attn_unit(lds, P, (const bf16_t*)(ws + WS_VTA), OC, subg, (j & 31) >> 3, j & 7, 16 - (j >> 5), lam, 1.f - lam_init);
                    }
                }
            }
            SEAM();
        }
        for (int rp = 0; rp < RP_G2; ++rp) if (IN_PH()) {
            PH_VARS();
            { pg8::Gemm g{(bf16_t*)(ws + WS_OC), (bf16_t*)(ws + WS_WOUT) + (size_t)l * DM * DM, MP, DM, DM, DM}; pg8::FullOrder32 S{G, bx};
              pg8::EpiF32 E{(float*)(ws + WS_Y), DM};
              pg8::gemm_phase<pg8::EpiF32, pg8::FullOrder32, true, true>(ldsa, g, S, E); }
            __builtin_amdgcn_sched_barrier(0); asm volatile("" : "+s"(bx) :: "memory"); __builtin_amdgcn_sched_barrier(0);
            { int kp = 256; asm volatile("" : "+s"(kp)); pg8::Gemm g{(bf16_t*)(ws + WS_OC), (bf16_t*)(ws + WS_WOUT) + (size_t)l * DM * DM, MP, DM, kp, DM}; pg8::SplitOrder32 S{G, bx, 8, kp};
              pg8::EpiPart E{(float*)(ws + WS_PART), DM, kp};
              pg8::gemm_phase<pg8::EpiPart, pg8::SplitOrder32, true, true>(ldsa, g, S, E); }
        }
        SEAM();
#ifndef NO_ROW
#ifdef RP_ROW
        if (IN_PH()) { PH_VARS(); row_phase<1>(nullptr, nullptr, nullptr, (float*)(ws + WS_X), (float*)(ws + WS_KV), (const float*)(ws + WS_Y), (const float*)(ws + WS_PART), 8, (bf16_t*)(ws + WS_SP), LDF(T_POST_MIX_G) + (size_t)l * DM, LDF(T_PRE_FFN_G) + (size_t)l * DM, gw, ngw, lane); }
#endif
        if (IN_PH()) { PH_VARS(); row_phase<1>(nullptr, nullptr, nullptr, (float*)(ws + WS_X), (float*)(ws + WS_X), (const float*)(ws + WS_Y), (const float*)(ws + WS_PART), 8, (bf16_t*)(ws + WS_H), LDF(T_POST_MIX_G) + (size_t)l * DM, LDF(T_PRE_FFN_G) + (size_t)l * DM, gw, ngw, lane); }
#endif
        SEAM();
        for (int rp = 0; rp < RP_G3; ++rp) if (IN_PH()) {
            PH_VARS();
            pg8::Gemm g{(bf16_t*)(ws + WS_H), (bf16_t*)(ws + WS_WUP) + (size_t)l * DFF2 * DM, 34 * 256, DFF2, DM}; pg8::StaticOrder S; S.init(34 * 256, DFF2, G, bx, 254, -2);
            pg8::EpiConvGate E{(bf16_t*)(ws + WS_G), LDF(T_CONV_W) + (size_t)l * 3 * DFF2, LDF(T_CONV_B) + (size_t)l * DFF2, (LAS float*)(ldsa + HALO_OFF), MP, LP, DFF, DFF};
            pg8::gemm_phase<pg8::EpiConvGate, pg8::StaticOrder, true, true>(ldsa, g, S, E);
        }
        SEAM();
        for (int rp = 0; rp < RP_G4; ++rp) if (IN_PH()) {
            PH_VARS();
            { pg8::Gemm g{(bf16_t*)(ws + WS_G), (bf16_t*)(ws + WS_WDN) + (size_t)l * DM * DFF, MP, DM, DFF, DFF}; pg8::FullOrder32 S{G, bx};
              pg8::EpiF32 E{(float*)(ws + WS_Y), DM};
              pg8::gemm_phase<pg8::EpiF32, pg8::FullOrder32, true, true>(ldsa, g, S, E); }
            __builtin_amdgcn_sched_barrier(0); asm volatile("" : "+s"(bx) :: "memory"); __builtin_amdgcn_sched_barrier(0);
            { int kp = 256; asm volatile("" : "+s"(kp)); pg8::Gemm g{(bf16_t*)(ws + WS_G), (bf16_t*)(ws + WS_WDN) + (size_t)l * DM * DFF, MP, DM, kp, DFF}; pg8::SplitOrder32 S{G, bx, 22, kp};
              pg8::EpiPart E{(float*)(ws + WS_PART), DM, kp};
              pg8::gemm_phase<pg8::EpiPart, pg8::SplitOrder32, true, true>(ldsa, g, S, E); }
        }
        SEAM();
#ifndef NO_ROW
        if (IN_PH()) {
            PH_VARS();
            if (l + 1 < DEPTH) row_phase<1>(nullptr, nullptr, nullptr, (float*)(ws + WS_X), (float*)(ws + WS_X), (const float*)(ws + WS_Y), (const float*)(ws + WS_PART), 22, (bf16_t*)(ws + WS_H), LDF(T_POST_FFN_G) + (size_t)l * DM, LDF(T_PRE_MIX_G) + (size_t)(l + 1) * DM, gw, ngw, lane);
            else row_phase<2>(nullptr, nullptr, (float*)ldp_(lds, T_OUT), (float*)(ws + WS_X), (float*)(ws + WS_X), (const float*)(ws + WS_Y), (const float*)(ws + WS_PART), 22, nullptr, LDF(T_POST_FFN_G) + (size_t)l * DM, nullptr, gw, ngw, lane);
        }
#endif
        if (l + 1 < DEPTH) SEAM(); else ++ph;
    }
#undef IN_PH
#undef SEAM
}
constexpr int N_PHASES = 1 + 9 * DEPTH;

#ifndef MULTI_LAUNCH
#define MULTI_LAUNCH 0
#endif
extern "C" void kernel_launch(void* const* d_in, const int* in_sizes, int n_in, void* d_out, int out_size, void* d_ws, size_t ws_size, hipStream_t stream) {
    static int grid = 0;
    if (grid == 0) {
        if (n_in != 17 || ws_size < WS_END) { fprintf(stderr, "kernel_launch: need 17 inputs and %zu bytes of workspace (got %d, %zu)\n", (size_t)WS_END, n_in, ws_size); grid = -1; return; }
        int dev = 0, cus = 0, per_cu = 0;
        hipGetDevice(&dev); hipDeviceGetAttribute(&cus, hipDeviceAttributeMultiprocessorCount, dev);
        if (hipFuncSetAttribute((const void*)hymba_fwd, hipFuncAttributeMaxDynamicSharedMemorySize, LDS_BYTES) != hipSuccess) { fprintf(stderr, "kernel_launch: hipFuncSetAttribute failed\n"); grid = -1; return; }
        if (hipOccupancyMaxActiveBlocksPerMultiprocessor(&per_cu, (const void*)hymba_fwd, NTHR, LDS_BYTES) != hipSuccess || per_cu < 1) { fprintf(stderr, "kernel_launch: occupancy query gave %d\n", per_cu); per_cu = 1; }
        (void)hipGetLastError();
        grid = cus * (per_cu > 1 ? 1 : per_cu);
        if (grid * 256 < 65536) { fprintf(stderr, "kernel_launch: grid %d too small for the GLA scan mapping\n", grid); grid = -1; return; }
    }
    if (grid < 0) return;
    Params p{};
    const float** pp = (const float**)&p;
    for (int i = 0; i < 17; ++i) pp[i] = (const float*)d_in[i];
    p.out = (float*)d_out; p.ws = (unsigned char*)d_ws;
#if MULTI_LAUNCH
    for (int ph = 0; ph < N_PHASES; ++ph) { p.ph_lo = ph; p.ph_hi = ph + 1; hipLaunchKernelGGL(hymba_fwd, dim3(grid), dim3(NTHR), LDS_BYTES, stream, p); }
#else
    p.ph_lo = 0; p.ph_hi = N_PHASES;
    if (hipMemsetAsync((unsigned char*)d_ws + WS_CTL, 0, CTL_BYTES, stream) != hipSuccess) { fprintf(stderr, "kernel_launch: memset of the barrier words failed\n"); return; }
    void* args[] = {&p};
    hipError_t e = hipLaunchCooperativeKernel((const void*)hymba_fwd, dim3(grid), dim3(NTHR), args, LDS_BYTES, stream);
    if (e != hipSuccess) fprintf(stderr, "kernel_launch: cooperative launch failed: %s (grid %d)\n", hipGetErrorString(e), grid);
#endif
}
```
